# Optimizing an MI355X kernel written in HIP

```python
import math
import jax, jax.numpy as jnp
from jax import lax
import numpy as np

D_MODEL = 1024
BATCH = 16
SEQ = 256
DEPTH = 4
DEC_BATCH = 8
DEC_SEQ = 2048
PAST_LEN = 256

GRID_W = 64
N_MIXERS = 2
N_RG = (DEPTH + 1) // 2
N_MLA = DEPTH // 2
D_FF = 4 * D_MODEL
D_RNN = D_MODEL
RG_BLOCKS = 8
RG_BS = D_RNN // RG_BLOCKS
RG_C = 8.0
CONV_W = 4
CONV_LEFT = (CONV_W - 1) // 2
N_HEADS = 8
QK_NOPE = 128
QK_ROPE = 64
V_DIM = 128
Q_LORA = 512
KV_LORA = 256
ROPE_THETA = 10000.0
Q_BLOCK = 128
EPS = 1e-6

kernel_name = "hybrid_rglru_mla_diffusion_step"


def rms_norm(x, g):
    xf = x.astype(jnp.float32)
    y = xf * lax.rsqrt(jnp.mean(xf * xf, axis=-1, keepdims=True) + EPS)
    return (y * g.astype(jnp.float32)).astype(x.dtype)


def adaln_params(cond, w_ada, b_ada):
    mod = jax.nn.silu(cond) @ w_ada + b_ada
    return jnp.split(mod, 6, axis=-1)


def modulate(h, shift, scale):
    return h * (1 + scale[:, None, :]) + shift[:, None, :]


def sq_relu_mlp(h, w1, w2):
    a = jax.nn.relu(h @ w1)
    return (a * a) @ w2


def depthwise_conv(x, w, b):
    T = x.shape[1]
    xp = jnp.pad(x, ((0, 0), (CONV_LEFT, CONV_W - 1 - CONV_LEFT), (0, 0)))
    out = xp[:, 0:T] * w[0]
    for k in range(1, CONV_W):
        out = out + xp[:, k:k + T] * w[k]
    return out + b


def linear_scan(a, b, h0, reverse):
    idx = -1 if reverse else 0
    b = b.at[:, idx].add(a[:, idx] * h0)

    def combine(e1, e2):
        a1, b1 = e1
        a2, b2 = e2
        return a1 * a2, a2 * b1 + b2

    _, h = lax.associative_scan(combine, (a, b), axis=1, reverse=reverse)
    return h


def rglru_block(h, h0, w_in, conv_w, conv_b, wa, ba, wx, bx, lam, w_out):
    B, T, _ = h.shape
    xb, yb = jnp.split(h @ w_in, 2, axis=-1)
    yb = jax.nn.gelu(yb)
    xb = depthwise_conv(xb, conv_w, conv_b)
    xf = xb.astype(jnp.float32)
    xblk = xf.reshape(B, T, RG_BLOCKS, RG_BS)
    r = jnp.einsum('btnk,rnkj->rbtnj', xblk, wa.astype(jnp.float32)).reshape(2, B, T, D_RNN)
    i = jnp.einsum('btnk,rnkj->rbtnj', xblk, wx.astype(jnp.float32)).reshape(2, B, T, D_RNN)
    r = jax.nn.sigmoid(r + ba.astype(jnp.float32)[:, None, None, :])
    i = jax.nn.sigmoid(i + bx.astype(jnp.float32)[:, None, None, :])
    log_a = -RG_C * r * jax.nn.softplus(-lam.astype(jnp.float32))[:, None, None, :]
    a = jnp.exp(log_a)
    b = jnp.sqrt(-jnp.expm1(2.0 * log_a)) * (i * xf[None])
    h0f = h0.astype(jnp.float32)
    h_f = linear_scan(a[0], b[0], h0f[:, 0], reverse=False)
    h_b = linear_scan(a[1], b[1], h0f[:, 1], reverse=True)
    final = jnp.stack([h_f[:, -1], h_b[:, 0]], axis=1).astype(h.dtype)
    out = ((h_f + h_b).astype(h.dtype) * yb) @ w_out
    return out, final


def axial_rope_tables(n):
    rows = n // GRID_W
    row = jnp.repeat(jnp.arange(rows, dtype=jnp.float32), GRID_W)
    col = jnp.tile(jnp.arange(GRID_W, dtype=jnp.float32), rows)
    half = QK_ROPE // 2
    inv = ROPE_THETA ** (-jnp.arange(0, half, 2, dtype=jnp.float32) / half)
    ang = jnp.concatenate([row[:, None] * inv, col[:, None] * inv], axis=-1)
    return jnp.cos(ang), jnp.sin(ang)


def apply_rope(x, cos, sin):
    xf = x.astype(jnp.float32).reshape(x.shape[:-1] + (QK_ROPE // 2, 2))
    x1, x2 = xf[..., 0], xf[..., 1]
    out = jnp.stack([x1 * cos - x2 * sin, x1 * sin + x2 * cos], axis=-1)
    return out.reshape(x.shape).astype(x.dtype)


def mla_project(h, w_dqkv, g_q, g_kv, w_uq):
    B, T, _ = h.shape
    proj = h @ w_dqkv
    cq = rms_norm(proj[..., :Q_LORA], g_q)
    ckv = rms_norm(proj[..., Q_LORA:Q_LORA + KV_LORA], g_kv)
    kpe = proj[..., Q_LORA + KV_LORA:]
    q = (cq @ w_uq).reshape(B, T, N_HEADS, QK_NOPE + QK_ROPE)
    return q[..., :QK_NOPE], q[..., QK_NOPE:], ckv, kpe


def mla_kv(ckv, w_ukv):
    B, T, _ = ckv.shape
    kv = (ckv @ w_ukv).reshape(B, T, N_HEADS, QK_NOPE + V_DIM)
    return kv[..., :QK_NOPE], kv[..., QK_NOPE:]


def block_attention(q_nope, q_pe, k_nope, k_pe, v):
    B, S = q_nope.shape[:2]
    nb = S // Q_BLOCK
    qn = q_nope.reshape(B, nb, Q_BLOCK, N_HEADS, QK_NOPE).transpose(1, 0, 2, 3, 4)
    qp = q_pe.reshape(B, nb, Q_BLOCK, N_HEADS, QK_ROPE).transpose(1, 0, 2, 3, 4)
    scale = (QK_NOPE + QK_ROPE) ** -0.5

    def one_block(args):
        qn_b, qp_b = args
        s = (jnp.einsum('bqhd,bkhd->bhqk', qn_b, k_nope)
             + jnp.einsum('bqhd,bkd->bhqk', qp_b, k_pe))
        p = jax.nn.softmax(s.astype(jnp.float32) * scale, axis=-1).astype(v.dtype)
        return jnp.einsum('bhqk,bkhd->bqhd', p, v)

    o = lax.map(one_block, (qn, qp))
    return o.transpose(1, 0, 2, 3, 4).reshape(B, S, N_HEADS * V_DIM)


def setup_inputs(seed: int = 0) -> dict:
    key = jax.random.key(seed)
    ks = iter(jax.random.split(key, 40))
    f32 = jnp.float32

    def nrm(shape, scale):
        return jax.random.normal(next(ks), shape, f32) * scale

    u = jax.random.uniform(next(ks), (N_RG, 2, D_RNN), f32, 0.9, 0.999)
    rg_lambda = jnp.log(u) - jnp.log1p(-u)
    return {
        "x_prompt": nrm((BATCH, SEQ, D_MODEL), 1.0),
        "x_sample": nrm((DEC_BATCH, DEC_SEQ, D_MODEL), 1.0),
        "state_rglru": nrm((DEC_BATCH, N_RG, 2, D_RNN), 0.5),
        "cache_ckv": nrm((DEC_BATCH, N_MLA, PAST_LEN, KV_LORA), 1.0),
        "cache_kpe": nrm((DEC_BATCH, N_MLA, PAST_LEN, QK_ROPE), 1.0),
        "c": nrm((DEC_BATCH, D_MODEL), 1.0),
        "c_ctx": nrm((D_MODEL,), 1.0),
        "ada_w": nrm((DEPTH, D_MODEL, 6 * D_MODEL), 0.5 * D_MODEL ** -0.5),
        "ada_b": nrm((DEPTH, 6 * D_MODEL), 0.02),
        "norm_mix": 1.0 + nrm((DEPTH, D_MODEL), 0.02),
        "norm_mlp": 1.0 + nrm((DEPTH, D_MODEL), 0.02),
        "mlp_w1": nrm((DEPTH, D_MODEL, D_FF), D_MODEL ** -0.5),
        "mlp_w2": nrm((DEPTH, D_FF, D_MODEL), D_FF ** -0.5),
        "rg_w_in": nrm((N_RG, D_MODEL, 2 * D_RNN), D_MODEL ** -0.5),
        "rg_conv_w": nrm((N_RG, CONV_W, D_RNN), CONV_W ** -0.5),
        "rg_conv_b": nrm((N_RG, D_RNN), 0.01),
        "rg_wa": nrm((N_RG, 2, RG_BLOCKS, RG_BS, RG_BS), RG_BS ** -0.5),
        "rg_ba": nrm((N_RG, 2, D_RNN), 0.01),
        "rg_wx": nrm((N_RG, 2, RG_BLOCKS, RG_BS, RG_BS), RG_BS ** -0.5),
        "rg_bx": nrm((N_RG, 2, D_RNN), 0.01),
        "rg_lambda": rg_lambda,
        "rg_w_out": nrm((N_RG, D_RNN, D_MODEL), D_RNN ** -0.5),
        "mla_w_dqkv": nrm((N_MLA, D_MODEL, Q_LORA + KV_LORA + QK_ROPE), D_MODEL ** -0.5),
        "mla_norm_q": 1.0 + nrm((N_MLA, Q_LORA), 0.02),
        "mla_norm_kv": 1.0 + nrm((N_MLA, KV_LORA), 0.02),
        "mla_w_uq": nrm((N_MLA, Q_LORA, N_HEADS * (QK_NOPE + QK_ROPE)), Q_LORA ** -0.5),
        "mla_w_ukv": nrm((N_MLA, KV_LORA, N_HEADS * (QK_NOPE + V_DIM)), KV_LORA ** -0.5),
        "mla_w_o": nrm((N_MLA, N_HEADS * V_DIM, D_MODEL), (N_HEADS * V_DIM) ** -0.5),
        "final_norm": 1.0 + nrm((D_MODEL,), 0.02),
    }


def reference(x_prompt, x_sample, state_rglru, cache_ckv, cache_kpe, c, c_ctx,
              ada_w, ada_b, norm_mix, norm_mlp, mlp_w1, mlp_w2,
              rg_w_in, rg_conv_w, rg_conv_b, rg_wa, rg_ba, rg_wx, rg_bx, rg_lambda, rg_w_out,
              mla_w_dqkv, mla_norm_q, mla_norm_kv, mla_w_uq, mla_w_ukv, mla_w_o,
              final_norm):
    xc = x_prompt
    cond_ctx = jnp.broadcast_to(c_ctx, (xc.shape[0], D_MODEL))
    rg_states, ckv_list, kpe_list = [], [], []
    for l in range(DEPTH):
        sh1, sc1, g1, sh2, sc2, g2 = adaln_params(cond_ctx, ada_w[l], ada_b[l])
        h = modulate(rms_norm(xc, norm_mix[l]), sh1, sc1)
        j = l // N_MIXERS
        if l % N_MIXERS == 0:
            h0 = jnp.zeros((xc.shape[0], 2, D_RNN), xc.dtype)
            out, fin = rglru_block(h, h0, rg_w_in[j], rg_conv_w[j], rg_conv_b[j], rg_wa[j], rg_ba[j],
                                   rg_wx[j], rg_bx[j], rg_lambda[j], rg_w_out[j])
            rg_states.append(fin)
        else:
            q_nope, q_pe, ckv, kpe = mla_project(h, mla_w_dqkv[j], mla_norm_q[j], mla_norm_kv[j], mla_w_uq[j])
            k_nope, v = mla_kv(ckv, mla_w_ukv[j])
            out = block_attention(q_nope, q_pe, k_nope, kpe, v) @ mla_w_o[j]
            ckv_list.append(ckv)
            kpe_list.append(kpe)
        xc = xc + g1[:, None, :] * out
        h = modulate(rms_norm(xc, norm_mlp[l]), sh2, sc2)
        xc = xc + g2[:, None, :] * sq_relu_mlp(h, mlp_w1[l], mlp_w2[l])
    y_prompt = rms_norm(xc, final_norm)
    new_state_rglru = jnp.stack(rg_states, axis=1)
    new_cache_ckv = jnp.stack(ckv_list, axis=1)
    new_cache_kpe = jnp.stack(kpe_list, axis=1)

    xs = x_sample
    n_lat = xs.shape[1]
    cos, sin = axial_rope_tables(n_lat)
    for l in range(DEPTH):
        sh1, sc1, g1, sh2, sc2, g2 = adaln_params(c, ada_w[l], ada_b[l])
        h = modulate(rms_norm(xs, norm_mix[l]), sh1, sc1)
        j = l // N_MIXERS
        if l % N_MIXERS == 0:
            out, _ = rglru_block(h, state_rglru[:, j], rg_w_in[j], rg_conv_w[j], rg_conv_b[j], rg_wa[j],
                                 rg_ba[j], rg_wx[j], rg_bx[j], rg_lambda[j], rg_w_out[j])
        else:
            q_nope, q_pe, ckv, kpe = mla_project(h, mla_w_dqkv[j], mla_norm_q[j], mla_norm_kv[j], mla_w_uq[j])
            q_pe = apply_rope(q_pe, cos[:, None, :], sin[:, None, :])
            kpe = apply_rope(kpe, cos, sin)
            k_nope_l, v_l = mla_kv(ckv, mla_w_ukv[j])
            k_nope_c, v_c = mla_kv(cache_ckv[:, j], mla_w_ukv[j])
            k_nope = jnp.concatenate([k_nope_l, k_nope_c], axis=1)
            k_pe = jnp.concatenate([kpe, cache_kpe[:, j]], axis=1)
            v = jnp.concatenate([v_l, v_c], axis=1)
            out = block_attention(q_nope, q_pe, k_nope, k_pe, v) @ mla_w_o[j]
        xs = xs + g1[:, None, :] * out
        h = modulate(rms_norm(xs, norm_mlp[l]), sh2, sc2)
        xs = xs + g2[:, None, :] * sq_relu_mlp(h, mlp_w1[l], mlp_w2[l])
    y_sample = rms_norm(xs, final_norm)

    return (y_prompt, y_sample, new_state_rglru, new_cache_ckv, new_cache_kpe)
```

```cpp
#include <hip/hip_runtime.h>
#include <hip/hip_cooperative_groups.h>
#include <cstdio>
#include <cstdint>
namespace cg = cooperative_groups;

#define LAS __attribute__((address_space(3)))
typedef unsigned short bf16_t;
typedef short bf16x8 __attribute__((ext_vector_type(8)));
typedef float f32x4 __attribute__((ext_vector_type(4)));
typedef float f32x2 __attribute__((ext_vector_type(2)));
typedef float f32x16 __attribute__((ext_vector_type(16)));
typedef unsigned u32x4 __attribute__((ext_vector_type(4)));
typedef unsigned u32x2 __attribute__((ext_vector_type(2)));

constexpr int D = 1024, MCTX = 4096, M = 20480, FF = 4096, MKV = 22528, KVB = 2304;
constexpr int QW = 1536;
constexpr size_t MiB = 1u << 20;
constexpr size_t WS_MOD = 0, WS_ROPE = 1 * MiB, WS_SP = 1 * MiB + 512 * 1024, WS_BAR = 1 * MiB + 768 * 1024, BAR_BYTES = 16384;
constexpr size_t WS_W1T = 2 * MiB, WS_W2T = 34 * MiB, WS_WINT = 66 * MiB, WS_WGT = 74 * MiB, WS_WOUTT = 76 * MiB, WS_WDQT = 80 * MiB,
                 WS_WUQT = 84 * MiB, WS_WUKT = 87 * MiB, WS_WUVT = 88 * MiB, WS_WOT = 89 * MiB;
constexpr size_t WS_SW = 93 * MiB, WS_SS = 94 * MiB, WS_H = 96 * MiB, WS_S = 136 * MiB, WS_END = 384 * MiB;
constexpr size_t S_A2 = WS_S, S_PART = WS_S + 160 * MiB;
constexpr size_t S_YB = WS_S, S_XC = WS_S + 40 * MiB, S_AB = WS_S + 80 * MiB, S_XB = S_AB, S_CAR = S_XC, S_G = S_YB;
constexpr size_t S_PROJ = WS_S, S_CQ = WS_S + 80 * MiB, S_CKV = WS_S + 100 * MiB, S_KPE = WS_S + 111 * MiB, S_Q = WS_S + 114 * MiB,
                 S_KN = WS_S + 174 * MiB, S_VT = WS_S, S_O = WS_S + 44 * MiB;
static_assert(S_KN + (size_t)MKV * 1024 * 2 <= WS_END && S_AB + 160 * MiB <= WS_END && S_O + 40 * MiB <= S_CKV && S_VT + 44 * MiB <= S_O, "ws map");
constexpr size_t OUT_STATE = (size_t)M * D, OUT_CKV = OUT_STATE + 65536, OUT_KPE = OUT_CKV + 2097152;

constexpr int LDS_BYTES = 147456;

__device__ __forceinline__ unsigned f2bf(float f) { unsigned u = __builtin_bit_cast(unsigned, f); return (u + 0x7fffu + ((u >> 16) & 1u)) >> 16; }
__device__ __forceinline__ unsigned pk2(float lo, float hi) { unsigned r; asm volatile("v_cvt_pk_bf16_f32 %0, %1, %2" : "=v"(r) : "v"(lo), "v"(hi)); return r; }
__device__ __forceinline__ float bflo(unsigned u) { return __builtin_bit_cast(float, u << 16); }
__device__ __forceinline__ float bfhi(unsigned u) { return __builtin_bit_cast(float, u & 0xffff0000u); }
__device__ __forceinline__ float shfl_xor_l(float v, int lane, int o) { return __builtin_bit_cast(float, __builtin_amdgcn_ds_bpermute((lane ^ o) << 2, __builtin_bit_cast(int, v))); }
__device__ __forceinline__ float wave_sum(float v, int lane) {
#pragma unroll
    for (int o = 1; o < 64; o <<= 1) v += shfl_xor_l(v, lane, o);
    return v;
}
struct Params;
typedef const __attribute__((address_space(4))) Params* KArgP;
__device__ __forceinline__ KArgP opaque_kernarg() { auto q = __builtin_amdgcn_kernarg_segment_ptr(); asm volatile("" : "+s"(q)); return (KArgP)q; }
__device__ __forceinline__ int opaque_tid() { int t = threadIdx.x; asm volatile("" : "+v"(t)); return t; }
__device__ __forceinline__ int opaque_bid() { int b = blockIdx.x; asm volatile("" : "+s"(b)); return b; }
__device__ __forceinline__ float sigmoidf_(float x) { return __builtin_amdgcn_rcpf(1.f + __expf(-x)); }
__device__ __forceinline__ int cond_of_tile(int pm) { return pm < 16 ? 0 : 1 + ((pm - 16) >> 3); }

namespace pg8 {
constexpr int BM = 256, BK = 64, HALF = 128, HTB = HALF * BK * 2, STAGE_BYTES = 8 * HTB, NXCD = 8, WGM = 8;
__host__ __device__ __forceinline__ int lds_byte(int r, int c) { const int st = (r >> 4) * 2 + (c >> 5), rr = r & 15, cc = c & 31, ob = rr * 64 + cc * 2; return st * 1024 + (ob ^ (((ob >> 9) & 1) << 5)); }
__host__ __device__ __forceinline__ void stage_rc(int b, int& R, int& C) { const int st = b / 1024, sb = b % 1024, swz = sb ^ (((sb >> 9) & 1) << 5); R = (st >> 1) * 16 + swz / 64; C = (st & 1) * 32 + (swz % 64) / 2; }
__host__ __device__ __forceinline__ int perm32(int rho) { const int n = rho >> 4, i = rho & 15; return 8 * (i >> 2) + 4 * n + (i & 3); }

struct Unit { int pm, pn, kq, idx; };
struct Gemm { const bf16_t* A; const bf16_t* Bt; int lda, ldb, K, a_sh, a_colbytes, kq_bytes; };

__device__ __forceinline__ void unit_of(int wgid, int nM, int nN, Unit& u) {
    const int nwg = nM * nN;
    { const int q = nwg / NXCD, r = nwg % NXCD, xcd = wgid % NXCD, off = wgid / NXCD; wgid = (xcd < r ? xcd * (q + 1) : r * (q + 1) + (xcd - r) * q) + off; }
    const int nig = WGM * nN, gid = wgid / nig, fm = gid * WGM, gsz = (nM - fm) < WGM ? (nM - fm) : WGM;
    u.pm = fm + ((wgid % nig) % gsz); u.pn = (wgid % nig) / gsz; u.kq = 0;
}
struct StaticOrder {
    int nM, nN, lim, G, c;
    __device__ void init(int M_, int N_, int G_, int c_) { nM = M_ / BM; nN = N_ / BM; lim = nM * nN; G = G_; c = c_; }
    __device__ bool next(int i, Unit& u) const {
        const long L = (long)i * G + c; if (L >= lim) return false;
        unit_of((int)L, nM, nN, u); u.idx = i; return true;
    }
};
struct SplitOrder {
    int nM, nN, base, c;
    __device__ bool next(int i, Unit& u) const {
        if (i > 0) return false; const int L = base + (c >> 2); if (L >= nM * nN) return false;
        unit_of(L, nM, nN, u); u.kq = c & 3; u.idx = 0; return true;
    }
};

__device__ __forceinline__ unsigned cvt_pk_bf16(float lo, float hi) { unsigned r; asm volatile("v_cvt_pk_bf16_f32 %0, %1, %2" : "=v"(r) : "v"(lo), "v"(hi)); return r; }

template <class Epi, class Sched, bool ALIGN_EPI = false, bool SP2 = false>
__device__ __forceinline__ void gemm_phase(LAS unsigned char* lds, const Gemm g, const Sched& S, const Epi& E) {
    const int tid = opaque_tid(), wid = __builtin_amdgcn_readfirstlane(tid >> 6), lane = tid & 63, wr = wid >> 2, wc = wid & 3, fr = lane & 15, fq = lane >> 4;
    int K_ = g.K; asm volatile("" : "+s"(K_)); const int K = K_, nt = K / BK;
    unsigned voffA[2], voffB[2];
#pragma unroll
    for (int i = 0; i < 2; ++i) { int R, C; stage_rc(tid * 16 + i * 8192, R, C); const int Rb = Epi::PERM ? ((R & ~31) + perm32(R & 31)) : R;
        voffA[i] = (unsigned)(R * g.lda + C) * 2u; voffB[i] = (unsigned)(Rb * g.ldb + C) * 2u; }
    const size_t kstep = (size_t)(BK * 2);
    const size_t hA = (size_t)HALF * g.lda * 2, hB = (size_t)HALF * g.ldb * 2;
    const size_t tA = 2 * hA, tB = 2 * hB;
    const unsigned ldsw = (unsigned)wid * 1024u;
    const int aoff = lds_byte(wr * 64 + fr, fq * 8), boff = lds_byte(wc * 32 + fr, fq * 8);
#define PG8_SA(b, h) (((b) * 2 + (h)) * HTB)
#define PG8_SB(b, h) ((4 + (b) * 2 + (h)) * HTB)
#define PG8_STAGE(bufoff, gbase, voff) do { const char* _gb = (const char*)(gbase); asm volatile("" : "+s"(_gb)); _Pragma("unroll") for (int _i = 0; _i < 2; ++_i) \
        __builtin_amdgcn_global_load_lds((const unsigned*)(_gb + (voff)[_i]), (LAS unsigned*)(lds + (bufoff) + ldsw + _i * 8192), 16, 0, 0); } while (0)
#define PG8_LDA(dst, b, h) do { _Pragma("unroll") for (int m = 0; m < 4; ++m) _Pragma("unroll") for (int k = 0; k < 2; ++k) dst[m][k] = *(const LAS bf16x8*)(lds + PG8_SA(b, h) + aoff + m * 2048 + k * 1024); } while (0)
#define PG8_LDB(dst, b, h) do { _Pragma("unroll") for (int n = 0; n < 2; ++n) _Pragma("unroll") for (int k = 0; k < 2; ++k) dst[n][k] = *(const LAS bf16x8*)(lds + PG8_SB(b, h) + boff + n * 2048 + k * 1024); } while (0)
#define PG8_MMA(ai, bj, At, Bt) do { __builtin_amdgcn_s_setprio(1); _Pragma("unroll") for (int m = 0; m < 4; ++m) _Pragma("unroll") for (int n = 0; n < 2; ++n) _Pragma("unroll") for (int k = 0; k < 2; ++k) \
        acc[ai][bj][m][n] = __builtin_amdgcn_mfma_f32_16x16x32_bf16(Bt[n][k], At[m][k], acc[ai][bj][m][n], 0, 0, 0); __builtin_amdgcn_s_setprio(0); } while (0)
#define PG8_WAIT_V(n) asm volatile("s_waitcnt vmcnt(" #n ")" ::: "memory")
#define PG8_WAIT_L(n) asm volatile("s_waitcnt lgkmcnt(" #n ")" ::: "memory")
#define PG8_BAR __builtin_amdgcn_s_barrier()
#define PG8_SCHED __builtin_amdgcn_sched_barrier(0)
#define PG8_OFFA(u) ((size_t)(u).pm * tA + (size_t)((u).pn >> g.a_sh) * (size_t)g.a_colbytes + (size_t)(u).kq * (size_t)g.kq_bytes)
#define PG8_OFFB(u) ((size_t)(u).pn * tB + (size_t)(u).kq * (size_t)g.kq_bytes)
    Unit cur, nxt; int ui = 0;
    if (!S.next(0, cur)) return;
    f32x4 acc[2][2][4][2];
#pragma unroll
    for (int a = 0; a < 2; ++a)
#pragma unroll
        for (int b = 0; b < 2; ++b)
#pragma unroll
            for (int m = 0; m < 4; ++m)
#pragma unroll
                for (int n = 0; n < 2; ++n) acc[a][b][m][n] = (f32x4){0.f, 0.f, 0.f, 0.f};
    bf16x8 At[4][2], B0[2][2], B1[2][2];
    const char* cA = (const char*)g.A + PG8_OFFA(cur); const char* cB = (const char*)g.Bt + PG8_OFFB(cur);
    if constexpr (SP2) {
        PG8_STAGE(PG8_SB(0, 0), cB, voffB); PG8_STAGE(PG8_SB(0, 1), cB + hB, voffB); PG8_STAGE(PG8_SA(0, 0), cA, voffA); PG8_STAGE(PG8_SA(0, 1), cA + hA, voffA);
        if (wr == 1) PG8_BAR;
        PG8_WAIT_V(2); PG8_BAR;
        PG8_STAGE(PG8_SB(1, 0), cB + kstep, voffB); PG8_STAGE(PG8_SA(1, 0), cA + kstep, voffA); PG8_STAGE(PG8_SB(1, 1), cB + hB + kstep, voffB);
        PG8_WAIT_V(6); PG8_BAR;
    } else {
        PG8_STAGE(PG8_SB(0, 0), cB, voffB); PG8_STAGE(PG8_SA(0, 0), cA, voffA); PG8_STAGE(PG8_SB(0, 1), cB + hB, voffB); PG8_STAGE(PG8_SA(0, 1), cA + hA, voffA);
        if (wr == 1) PG8_BAR;
        PG8_WAIT_V(4); PG8_BAR;
        PG8_STAGE(PG8_SB(1, 0), cB + kstep, voffB); PG8_STAGE(PG8_SA(1, 0), cA + kstep, voffA); PG8_STAGE(PG8_SB(1, 1), cB + hB + kstep, voffB);
        PG8_WAIT_V(6); PG8_BAR;
    }
    for (;;) {
        const bool has_next = S.next(ui + 1, nxt);
        const char* nA = has_next ? (const char*)g.A + PG8_OFFA(nxt) : cA; const char* nB = has_next ? (const char*)g.Bt + PG8_OFFB(nxt) : cB;
        for (int t = 0; t < nt; t += 2) {
            const bool last = (t == nt - 2);
            const char* a1 = cA + (size_t)(t + 1) * kstep;
            const char* a2 = last ? nA : cA + (size_t)(t + 2) * kstep; const char* b2 = last ? nB : cB + (size_t)(t + 2) * kstep;
            const char* a3 = a2 + kstep; const char* b3 = b2 + kstep;
            if constexpr (SP2) {
            PG8_LDB(B0, 0, 0); PG8_LDB(B1, 0, 1); PG8_SCHED; PG8_LDA(At, 0, 0); PG8_STAGE(PG8_SA(1, 1), a1 + hA, voffA);
            PG8_WAIT_V(8); PG8_WAIT_L(0); PG8_BAR; PG8_MMA(0, 0, At, B0); PG8_MMA(0, 1, At, B1); PG8_BAR; PG8_SCHED;
            PG8_LDA(At, 0, 1); PG8_STAGE(PG8_SB(0, 0), b2, voffB); PG8_STAGE(PG8_SB(0, 1), b2 + hB, voffB); PG8_STAGE(PG8_SA(0, 0), a2, voffA);
            PG8_WAIT_V(8); PG8_WAIT_L(0); PG8_BAR; PG8_MMA(1, 0, At, B0); PG8_MMA(1, 1, At, B1); PG8_BAR; PG8_SCHED;
            PG8_LDB(B0, 1, 0); PG8_LDB(B1, 1, 1); PG8_SCHED; PG8_LDA(At, 1, 0); PG8_STAGE(PG8_SA(0, 1), a2 + hA, voffA);
            PG8_WAIT_V(8); PG8_WAIT_L(0); PG8_BAR; PG8_MMA(0, 0, At, B0); PG8_MMA(0, 1, At, B1); PG8_BAR; PG8_SCHED;
            PG8_LDA(At, 1, 1); PG8_STAGE(PG8_SB(1, 0), b3, voffB); PG8_STAGE(PG8_SB(1, 1), b3 + hB, voffB); PG8_STAGE(PG8_SA(1, 0), a3, voffA);
            PG8_WAIT_V(8); PG8_WAIT_L(0); PG8_BAR; PG8_MMA(1, 0, At, B0); PG8_MMA(1, 1, At, B1); PG8_BAR; PG8_SCHED;
            } else {
            PG8_LDB(B0, 0, 0); PG8_SCHED; PG8_LDA(At, 0, 0); PG8_STAGE(PG8_SA(1, 1), a1 + hA, voffA);
            PG8_WAIT_L(8); PG8_BAR; PG8_WAIT_L(0); PG8_MMA(0, 0, At, B0); PG8_BAR; PG8_SCHED;
            PG8_LDB(B1, 0, 1); PG8_STAGE(PG8_SB(0, 0), b2, voffB);
            PG8_BAR; PG8_WAIT_L(0); PG8_MMA(0, 1, At, B1); PG8_BAR;
            PG8_LDA(At, 0, 1); PG8_STAGE(PG8_SA(0, 0), a2, voffA);
            PG8_BAR; PG8_WAIT_L(0); PG8_MMA(1, 0, At, B0); PG8_BAR; PG8_SCHED;
            PG8_STAGE(PG8_SB(0, 1), b2 + hB, voffB);
            PG8_WAIT_V(6); PG8_BAR; PG8_MMA(1, 1, At, B1); PG8_BAR;
            PG8_LDB(B0, 1, 0); PG8_SCHED; PG8_LDA(At, 1, 0); PG8_STAGE(PG8_SA(0, 1), a2 + hA, voffA);
            PG8_WAIT_L(8); PG8_BAR; PG8_WAIT_L(0); PG8_MMA(0, 0, At, B0); PG8_BAR; PG8_SCHED;
            PG8_LDB(B1, 1, 1); PG8_STAGE(PG8_SB(1, 0), b3, voffB);
            PG8_BAR; PG8_WAIT_L(0); PG8_MMA(0, 1, At, B1); PG8_BAR;
            PG8_LDA(At, 1, 1); PG8_STAGE(PG8_SA(1, 0), a3, voffA);
            PG8_BAR; PG8_WAIT_L(0); PG8_MMA(1, 0, At, B0); PG8_BAR; PG8_SCHED;
            PG8_STAGE(PG8_SB(1, 1), b3 + hB, voffB);
            PG8_WAIT_V(6); PG8_BAR; PG8_MMA(1, 1, At, B1); PG8_BAR;
            }
        }
        if constexpr (ALIGN_EPI) { if (wr == 0) PG8_BAR; }
        { int t2 = threadIdx.x; asm volatile("" : "+v"(t2)); const int w2 = t2 >> 6, l2 = t2 & 63; E(acc, cur, w2 >> 2, w2 & 3, l2 & 15, l2 >> 4); }
        if (!has_next) break;
#pragma unroll
        for (int a = 0; a < 2; ++a)
#pragma unroll
            for (int b = 0; b < 2; ++b)
#pragma unroll
                for (int m = 0; m < 4; ++m)
#pragma unroll
                    for (int n = 0; n < 2; ++n) acc[a][b][m][n] = (f32x4){0.f, 0.f, 0.f, 0.f};
        cur = nxt; cA = nA; cB = nB; ++ui;
        if constexpr (ALIGN_EPI) { if (wr == 1) PG8_BAR; }
    }
    PG8_WAIT_V(0);
    if constexpr (!ALIGN_EPI) { if (wr == 0) PG8_BAR; }
    PG8_BAR;
#undef PG8_SA
#undef PG8_SB
#undef PG8_STAGE
#undef PG8_LDA
#undef PG8_LDB
#undef PG8_MMA
#undef PG8_WAIT_V
#undef PG8_WAIT_L
#undef PG8_BAR
#undef PG8_SCHED
#undef PG8_OFFA
#undef PG8_OFFB
}
}

typedef f32x4 AccT[2][2][4][2];

template <int MODE, bool NORM = false> struct EpiBf16 {
    static constexpr bool PERM = true;
    bf16_t* O; bf16_t* O2; int ldc; const float* ss; const float* sw;
    __device__ __forceinline__ void operator()(const AccT& acc, const pg8::Unit& u, int wr, int wc, int fr, int fq) const {
        const int row0 = u.pm * 256 + wr * 64 + fr; int colt = u.pn * 256; bf16_t* base = O; bool act = (MODE == 1);
        if (MODE == 2) { if (colt >= 1024) { colt -= 1024; base = O2; act = true; } }
        const int col0 = colt + wc * 32 + 8 * fq;
        f32x4 sv[2][2];
        if (NORM) { const float* swp = sw + (size_t)cond_of_tile(u.pm) * 6144 + u.pn * 256 + wc * 32 + 8 * fq;
#pragma unroll
            for (int bj = 0; bj < 2; ++bj) { sv[bj][0] = *(const f32x4*)(swp + bj * 128); sv[bj][1] = *(const f32x4*)(swp + bj * 128 + 4); } }
        float rsd[2][4];
        if (NORM) { f32x4 t[2][4]; const int lane = fq * 16 + fr;
#pragma unroll
            for (int ai = 0; ai < 2; ++ai)
#pragma unroll
                for (int m = 0; m < 4; ++m) t[ai][m] = *(const f32x4*)(ss + (size_t)(row0 + ai * 128 + m * 16) * 16 + 4 * fq);
#pragma unroll
            for (int ai = 0; ai < 2; ++ai)
#pragma unroll
                for (int m = 0; m < 4; ++m) { float q = (t[ai][m][0] + t[ai][m][1]) + (t[ai][m][2] + t[ai][m][3]); q += shfl_xor_l(q, lane, 16); q += shfl_xor_l(q, lane, 32);
                    rsd[ai][m] = rsqrtf(q * (1.f / 1024.f) + 1e-6f); } }
#pragma unroll
        for (int ai = 0; ai < 2; ++ai)
#pragma unroll
            for (int m = 0; m < 4; ++m) { const int row = row0 + ai * 128 + m * 16; bf16_t* rowp = base + (size_t)row * ldc + col0;
                float rstd = 1.f;
                if (NORM) rstd = rsd[ai][m];
#pragma unroll
                for (int bj = 0; bj < 2; ++bj) { f32x4 v0 = acc[ai][bj][m][0], v1 = acc[ai][bj][m][1];
                    if (NORM) { v0 = v0 * rstd + sv[bj][0]; v1 = v1 * rstd + sv[bj][1]; }
                    if (act) {
#pragma unroll
                        for (int j = 0; j < 4; ++j) {
                            if (MODE == 1) { float a = fmaxf(v0[j], 0.f), b = fmaxf(v1[j], 0.f); v0[j] = a * a; v1[j] = b * b; }
                            else { float x = v0[j], y = v1[j];
                                   float ux = 1.5957691216f * (x + 0.044715f * x * x * x), uy = 1.5957691216f * (y + 0.044715f * y * y * y);
                                   v0[j] = x * __builtin_amdgcn_rcpf(1.f + __expf(-ux)); v1[j] = y * __builtin_amdgcn_rcpf(1.f + __expf(-uy)); }
                        }
                    }
                    u32x4 w; w.x = pg8::cvt_pk_bf16(v0[0], v0[1]); w.y = pg8::cvt_pk_bf16(v0[2], v0[3]); w.z = pg8::cvt_pk_bf16(v1[0], v1[1]); w.w = pg8::cvt_pk_bf16(v1[2], v1[3]);
                    *(u32x4*)(rowp + bj * 128) = w; } }
    }
};
struct EpiF32 {
    static constexpr bool PERM = false;
    float* O; int ldc; const float* ss; const float* sw;
    __device__ __forceinline__ void operator()(const AccT& acc, const pg8::Unit& u, int wr, int wc, int fr, int fq) const {
        const int row0 = u.pm * 256 + wr * 64 + fr, col0 = u.pn * 256 + wc * 32 + 4 * fq;
        const float* swp = sw + (size_t)cond_of_tile(u.pm) * 6144 + col0;
        f32x4 sv[2][2];
#pragma unroll
        for (int bj = 0; bj < 2; ++bj)
#pragma unroll
            for (int n = 0; n < 2; ++n) sv[bj][n] = *(const f32x4*)(swp + bj * 128 + n * 16);
        float rsd[2][4];
        { f32x4 t[2][4]; const int lane = fq * 16 + fr;
#pragma unroll
            for (int ai = 0; ai < 2; ++ai)
#pragma unroll
                for (int m = 0; m < 4; ++m) t[ai][m] = *(const f32x4*)(ss + (size_t)(row0 + ai * 128 + m * 16) * 16 + 4 * fq);
#pragma unroll
            for (int ai = 0; ai < 2; ++ai)
#pragma unroll
                for (int m = 0; m < 4; ++m) { float q = (t[ai][m][0] + t[ai][m][1]) + (t[ai][m][2] + t[ai][m][3]); q += shfl_xor_l(q, lane, 16); q += shfl_xor_l(q, lane, 32);
                    rsd[ai][m] = rsqrtf(q * (1.f / 1024.f) + 1e-6f); } }
#pragma unroll
        for (int ai = 0; ai < 2; ++ai)
#pragma unroll
            for (int m = 0; m < 4; ++m) { const int row = row0 + ai * 128 + m * 16; float* rowp = O + (size_t)row * ldc + col0;
                const float rstd = rsd[ai][m];
#pragma unroll
                for (int bj = 0; bj < 2; ++bj)
#pragma unroll
                    for (int n = 0; n < 2; ++n) *(f32x4*)(rowp + bj * 128 + n * 16) = acc[ai][bj][m][n] * rstd + sv[bj][n]; }
    }
};
struct EpiResid {
    static constexpr bool PERM = true;
    const float* base0; const float* base1; float* out; const float* gate;
    bf16_t* XG; const float* gn; const float* sc; float* ss;
    __device__ __forceinline__ void operator()(const AccT& acc, const pg8::Unit& u, int wr, int wc, int fr, int fq) const {
        const int row0 = u.pm * 256 + wr * 64 + fr, col0 = u.pn * 256 + wc * 32 + 8 * fq, cnd = cond_of_tile(u.pm), lane = fq * 16 + fr;
        const float* gp = gate + (size_t)cnd * 6144 + col0;
        const float* bp = (u.pm < 16) ? base0 : base1 - (size_t)MCTX * D;
        const bool xg = XG != nullptr;
        f32x4 gv[2][2], gm[2][2]; float sqa[2][4];
#pragma unroll
        for (int bj = 0; bj < 2; ++bj)
#pragma unroll
            for (int n = 0; n < 2; ++n) { gv[bj][n] = *(const f32x4*)(gp + bj * 128 + n * 4);
                if (xg) gm[bj][n] = *(const f32x4*)(gn + col0 + bj * 128 + n * 4) * (*(const f32x4*)(sc + (size_t)cnd * 6144 + col0 + bj * 128 + n * 4) + 1.f);
                else gm[bj][n] = (f32x4){0.f, 0.f, 0.f, 0.f}; }
#pragma unroll
        for (int aim = 0; aim < 4; ++aim) { const int ai = aim >> 1, mb = (aim & 1) * 2;
            f32x4 bb[4][2][2];
#pragma unroll
            for (int m = mb; m < mb + 2; ++m)
#pragma unroll
                for (int bj = 0; bj < 2; ++bj)
#pragma unroll
                    for (int n = 0; n < 2; ++n) bb[m][bj][n] = *(const f32x4*)(bp + (size_t)(row0 + ai * 128 + m * 16) * D + col0 + bj * 128 + n * 4);
#pragma unroll
            for (int m = mb; m < mb + 2; ++m) { const int row = row0 + ai * 128 + m * 16; const size_t off = (size_t)row * D + col0; float sq = 0.f;
#pragma unroll
                for (int bj = 0; bj < 2; ++bj) {
                    const f32x4 x0 = bb[m][bj][0] + gv[bj][0] * acc[ai][bj][m][0], x1 = bb[m][bj][1] + gv[bj][1] * acc[ai][bj][m][1];
                    *(f32x4*)(out + off + bj * 128) = x0; *(f32x4*)(out + off + bj * 128 + 4) = x1;
                    if (xg) { sq += ((x0[0] * x0[0] + x0[1] * x0[1]) + (x0[2] * x0[2] + x0[3] * x0[3])) + ((x1[0] * x1[0] + x1[1] * x1[1]) + (x1[2] * x1[2] + x1[3] * x1[3]));
                        const f32x4 y0 = x0 * gm[bj][0], y1 = x1 * gm[bj][1];
                        *(u32x4*)(XG + off + bj * 128) = (u32x4){pg8::cvt_pk_bf16(y0[0], y0[1]), pg8::cvt_pk_bf16(y0[2], y0[3]), pg8::cvt_pk_bf16(y1[0], y1[1]), pg8::cvt_pk_bf16(y1[2], y1[3])}; } }
                sqa[ai][m] = sq; }
        }
        if (xg) {
#pragma unroll
            for (int ai = 0; ai < 2; ++ai)
#pragma unroll
                for (int m = 0; m < 4; ++m) sqa[ai][m] += shfl_xor_l(sqa[ai][m], lane, 16);
#pragma unroll
            for (int ai = 0; ai < 2; ++ai)
#pragma unroll
                for (int m = 0; m < 4; ++m) sqa[ai][m] += shfl_xor_l(sqa[ai][m], lane, 32);
            if (fq == 0) {
#pragma unroll
                for (int ai = 0; ai < 2; ++ai)
#pragma unroll
                    for (int m = 0; m < 4; ++m) ss[(size_t)(row0 + ai * 128 + m * 16) * 16 + u.pn * 4 + wc] = sqa[ai][m]; }
        }
    }
};
struct EpiGates {
    static constexpr bool PERM = true;
    const bf16_t* XC; unsigned* AB; const float* ba; const float* bx; const float* sp;
    __device__ __forceinline__ void operator()(const AccT& acc, const pg8::Unit& u, int wr, int wc, int fr, int fq) const {
        const int blk = u.pn >> 1, dir = u.pn & 1;
        const int row0 = u.pm * 256 + wr * 64 + fr, ch0 = blk * 128 + wc * 32 + 8 * fq;
        unsigned* ab = AB + (size_t)dir * M * 1024;
        u32x2 xwa[2][2][4];
#pragma unroll
        for (int n = 0; n < 2; ++n)
#pragma unroll
            for (int ai = 0; ai < 2; ++ai)
#pragma unroll
                for (int m = 0; m < 4; ++m) xwa[n][ai][m] = *(const u32x2*)(XC + (size_t)(row0 + ai * 128 + m * 16) * 1024 + ch0 + 4 * n);
#pragma unroll
        for (int n = 0; n < 2; ++n) {
            const f32x4 vba = *(const f32x4*)(ba + dir * 1024 + ch0 + 4 * n), vbx = *(const f32x4*)(bx + dir * 1024 + ch0 + 4 * n), vsp = *(const f32x4*)(sp + dir * 1024 + ch0 + 4 * n);
#pragma unroll
            for (int ai = 0; ai < 2; ++ai)
#pragma unroll
                for (int m = 0; m < 4; ++m) { const size_t off = (size_t)(row0 + ai * 128 + m * 16) * 1024 + ch0 + 4 * n;
                    const u32x2 xw = xwa[n][ai][m];
                    const float xf[4] = {bflo(xw.x), bfhi(xw.x), bflo(xw.y), bfhi(xw.y)};
                    unsigned o[4];
#pragma unroll
                    for (int j = 0; j < 4; ++j) {
                        const float r = sigmoidf_(acc[ai][0][m][n][j] + vba[j]);
                        const float la = -r * vsp[j];
                        const float uu = fmaxf(1.f - __expf(2.f * la), 1e-20f), vv = 1.f + __expf(-(acc[ai][1][m][n][j] + vbx[j]));
                        const float bb = uu * __builtin_amdgcn_rsqf(uu * vv * vv) * xf[j];
                        o[j] = pk2(la, bb); }
                    *(u32x4*)(ab + off) = (u32x4){o[0], o[1], o[2], o[3]};
                    __builtin_amdgcn_sched_barrier(0); }
        }
    }
};
struct EpiQ {
    static constexpr bool PERM = true;
    bf16_t* Q; const float* rope; float qscale;
    __device__ __forceinline__ void operator()(const AccT& acc, const pg8::Unit& u, int wr, int wc, int fr, int fq) const {
        const int row0 = u.pm * 256 + wr * 64 + fr;
#pragma unroll
        for (int bj = 0; bj < 2; ++bj) {
            const int col0 = u.pn * 256 + bj * 128 + wc * 32 + 8 * fq; const int within = col0 % 192;
            const bool pe = (within >= 128) && (u.pm >= 16); const int i0 = pe ? ((within - 128) >> 1) : 0;
            bf16_t* qp = Q + (size_t)row0 * QW + col0;
            const float* rp0 = rope + (size_t)i0 * 2;
#pragma unroll
            for (int ai = 0; ai < 2; ++ai)
#pragma unroll
                for (int m = 0; m < 4; ++m) { const int rr = ai * 128 + m * 16;
                    f32x4 v0 = acc[ai][bj][m][0], v1 = acc[ai][bj][m][1];
                    if (pe) { const int pos = (row0 + rr - MCTX) & 2047; const float* rp = rp0 + (size_t)pos * 64;
                        const f32x4 r0 = *(const f32x4*)rp, r1 = *(const f32x4*)(rp + 4);
                        const f32x4 a = v0, b = v1;
                        v0[0] = a[0] * r0[0] - a[1] * r0[1]; v0[1] = a[0] * r0[1] + a[1] * r0[0];
                        v0[2] = a[2] * r0[2] - a[3] * r0[3]; v0[3] = a[2] * r0[3] + a[3] * r0[2];
                        v1[0] = b[0] * r1[0] - b[1] * r1[1]; v1[1] = b[0] * r1[1] + b[1] * r1[0];
                        v1[2] = b[2] * r1[2] - b[3] * r1[3]; v1[3] = b[2] * r1[3] + b[3] * r1[2]; }
                    v0 = v0 * qscale; v1 = v1 * qscale;
                    u32x4 w; w.x = pg8::cvt_pk_bf16(v0[0], v0[1]); w.y = pg8::cvt_pk_bf16(v0[2], v0[3]); w.z = pg8::cvt_pk_bf16(v1[0], v1[1]); w.w = pg8::cvt_pk_bf16(v1[2], v1[3]);
                    *(u32x4*)(qp + (size_t)rr * QW) = w;
                    __builtin_amdgcn_sched_barrier(0); }
        }
    }
};

__device__ __forceinline__ void rstd_prepass(LAS float* rs, const float* ss, int Mr, int N) {
    pg8::StaticOrder S; S.init(Mr, N, (int)gridDim.x, opaque_bid());
    const int tid = opaque_tid(), lane = tid & 63, rl = tid >> 1, half = tid & 1;
    pg8::Unit u;
    for (int i = 0; S.next(i, u); ++i) {
        const float* sp = ss + (size_t)(u.pm * 256 + rl) * 16 + half * 8;
        const f32x4 a = *(const f32x4*)sp, b = *(const f32x4*)(sp + 4); const f32x4 t4 = a + b;
        float t = (t4[0] + t4[1]) + (t4[2] + t4[3]); t += shfl_xor_l(t, lane, 1);
        if (half == 0) rs[i * 256 + rl] = rsqrtf(t * (1.f / 1024.f) + 1e-6f);
    }
    __syncthreads();
}
template <class Epi>
__device__ __forceinline__ void run_gemm(LAS unsigned char* lds, const bf16_t* A, int lda, const bf16_t* Bt, int ldb, int Mr, int N, int K, int a_sh, int a_colbytes, const Epi& E, int lim = 1 << 30) {
    pg8::Gemm g{A, Bt, lda, ldb, K, a_sh, a_colbytes, 0};
    pg8::StaticOrder S; S.init(Mr, N, (int)gridDim.x, opaque_bid()); if (lim < S.lim) S.lim = lim;
    pg8::gemm_phase<Epi, pg8::StaticOrder, true, true>(lds, g, S, E);
}
struct EpiPartial {
    static constexpr bool PERM = false;
    float* part; int base, nM, nN;
    __device__ __forceinline__ void operator()(const AccT& acc, const pg8::Unit& u, int wr, int wc, int fr, int fq) const {
        const int slot = opaque_bid();
        float* O = part + (size_t)slot * 65536;
        const int row0 = wr * 64 + fr, col0 = wc * 32 + 4 * fq;
#pragma unroll
        for (int ai = 0; ai < 2; ++ai)
#pragma unroll
            for (int m = 0; m < 4; ++m) { float* rowp = O + (size_t)(row0 + ai * 128 + m * 16) * 256 + col0;
#pragma unroll
                for (int bj = 0; bj < 2; ++bj)
#pragma unroll
                    for (int n = 0; n < 2; ++n) *(f32x4*)(rowp + bj * 128 + n * 16) = acc[ai][bj][m][n]; }
    }
};
template <class Epi>
__device__ __forceinline__ void run_gemm_split(LAS unsigned char* lds, const bf16_t* A, int lda, const bf16_t* Bt, int ldb, int Mr, int N, int Kq, int base, const Epi& E) {
    pg8::Gemm g{A, Bt, lda, ldb, Kq, 0, 0, Kq * 2};
    pg8::SplitOrder S{Mr / 256, N / 256, base, opaque_bid()};
    pg8::gemm_phase<Epi, pg8::SplitOrder, true, true>(lds, g, S, E);
}
__device__ __forceinline__ void split_reduce_phase(const float* part, float* X, const float* gate, int base, int nM, int nN, bf16_t* XG, const float* gn, const float* sc, float* ss) {
    const int tid_ = opaque_tid(), lane = tid_ & 63; const int gt = opaque_bid() * 512 + tid_, NT = gridDim.x * 512;
    const int nsplit = nM * nN - base, nit = nsplit * 16384;
    for (int it0 = gt; it0 < nit; it0 += 4 * NT) {
        f32x4 p[4][4], xo[4], gv[4], gm[4]; int rowv[4], colv[4], pnv[4]; bool ok[4];
#pragma unroll
        for (int i = 0; i < 4; ++i) { const int it = it0 + i * NT; ok[i] = it < nit;
            const int itc = ok[i] ? it : it0;
            const int su = itc >> 14, e = itc & 16383, r = e >> 6, c4 = (e & 63) * 4;
            pg8::Unit u; pg8::unit_of(base + su, nM, nN, u);
            const float* pp = part + (size_t)su * 4 * 65536 + r * 256 + c4;
#pragma unroll
            for (int k4 = 0; k4 < 4; ++k4) p[i][k4] = *(const f32x4*)(pp + (size_t)k4 * 65536);
            rowv[i] = u.pm * 256 + r; colv[i] = u.pn * 256 + c4; pnv[i] = u.pn; const int cnd = cond_of_tile(u.pm);
            xo[i] = *(const f32x4*)(X + (size_t)rowv[i] * D + colv[i]);
            gv[i] = *(const f32x4*)(gate + (size_t)cnd * 6144 + colv[i]);
            if (XG != nullptr) gm[i] = *(const f32x4*)(gn + colv[i]) * (*(const f32x4*)(sc + (size_t)cnd * 6144 + colv[i]) + 1.f); else gm[i] = (f32x4){0.f, 0.f, 0.f, 0.f}; }
        float sq[4];
#pragma unroll
        for (int i = 0; i < 4; ++i) { const f32x4 s4 = (p[i][0] + p[i][1]) + (p[i][2] + p[i][3]); const f32x4 xn = xo[i] + gv[i] * s4;
            if (ok[i]) *(f32x4*)(X + (size_t)rowv[i] * D + colv[i]) = xn;
            sq[i] = (xn[0] * xn[0] + xn[1] * xn[1]) + (xn[2] * xn[2] + xn[3] * xn[3]);
            if (XG != nullptr && ok[i]) { const f32x4 y = xn * gm[i]; *(u32x2*)(XG + (size_t)rowv[i] * D + colv[i]) = (u32x2){pk2(y[0], y[1]), pk2(y[2], y[3])}; } }
        if (XG != nullptr) {
#pragma unroll
            for (int o_ = 1; o_ < 64; o_ <<= 1) {
#pragma unroll
                for (int i = 0; i < 4; ++i) sq[i] += shfl_xor_l(sq[i], lane, o_); }
#pragma unroll
            for (int i = 0; i < 4; ++i) if (ok[i] && lane < 4) ss[(size_t)rowv[i] * 16 + pnv[i] * 4 + lane] = lane == 0 ? sq[i] : 0.f;
        }
    }
}
__device__ __forceinline__ void sw_phase(const float* mod, const unsigned char* ws, float* sW) {
    const int tid_ = opaque_tid(), lane = tid_ & 63, gw = opaque_bid() * 8 + (tid_ >> 6), NGW = gridDim.x * 8;
    const int r16 = lane & 15, q = lane >> 4;
    for (int it = gw; it < 1408; it += NGW) {
        int l = 0, n0 = 0; bool up = false;
        { int r = it;
          for (int ll = 0; ll < 4; ++ll) { const int nmix = (ll & 1) ? 64 : 128;
              if (r < nmix) { l = ll; n0 = r * 16; up = false; break; } r -= nmix;
              if (r < 256) { l = ll; n0 = r * 16; up = true; break; } r -= 256; } }
        const int j = l >> 1;
        const bf16_t* wt;
        if (up) wt = (const bf16_t*)(ws + WS_W1T) + ((size_t)l * 4096 + n0) * 1024;
        else if (l & 1) wt = (const bf16_t*)(ws + WS_WDQT) + ((size_t)j * 1024 + n0) * 1024;
        else wt = (const bf16_t*)(ws + WS_WINT) + ((size_t)j * 2048 + n0) * 1024;
        const bf16_t* wp = wt + (size_t)r16 * 1024 + 8 * q;
        const bool cv = r16 < 9;
        const float* shp = mod + ((size_t)l * 9 + (cv ? r16 : 0)) * 6144 + (up ? 3 : 0) * 1024 + 8 * q;
        f32x4 acc = (f32x4){0.f, 0.f, 0.f, 0.f};
#pragma unroll 1
        for (int kb = 0; kb < 4; ++kb) {
            bf16x8 bfr[8]; f32x4 a0[8], a1[8];
#pragma unroll
            for (int s8 = 0; s8 < 8; ++s8) { const int k0 = kb * 256 + s8 * 32;
                bfr[s8] = *(const bf16x8*)(wp + k0); a0[s8] = *(const f32x4*)(shp + k0); a1[s8] = *(const f32x4*)(shp + k0 + 4); }
#pragma unroll
            for (int s8 = 0; s8 < 8; ++s8) { u32x4 aw;
                aw.x = pk2(a0[s8][0], a0[s8][1]); aw.y = pk2(a0[s8][2], a0[s8][3]); aw.z = pk2(a1[s8][0], a1[s8][1]); aw.w = pk2(a1[s8][2], a1[s8][3]);
                if (!cv) aw = (u32x4){0u, 0u, 0u, 0u};
                acc = __builtin_amdgcn_mfma_f32_16x16x32_bf16(__builtin_bit_cast(bf16x8, aw), bfr[s8], acc, 0, 0, 0); }
        }
#pragma unroll
        for (int i = 0; i < 4; ++i) { const int cnd = 4 * q + i; if (cnd < 9) sW[((size_t)l * 9 + cnd) * 6144 + (up ? 2048 : 0) + n0 + r16] = acc[i]; }
    }
}

struct Params { const float* in[29]; float* out; unsigned char* ws; int ph_lo, ph_hi; };
enum { I_XP = 0, I_XS, I_STATE, I_CCKV, I_CKPE, I_C, I_CCTX, I_ADAW, I_ADAB, I_NMIX, I_NMLP, I_W1, I_W2, I_WIN, I_CONVW, I_CONVB, I_WA, I_BA, I_WX, I_BX, I_LAM, I_WOUT,
       I_WDQ, I_NQ, I_NKV, I_WUQ, I_WUKV, I_WO, I_FN };

__device__ __forceinline__ void transpose_item(const float* src, int ldsrc, int k0, int n0, bf16_t* dstrow0, int lddst, LAS float* scr, int lane) {
#pragma unroll 8
    for (int i = 0; i < 32; ++i) { const int kk = 2 * i + (lane >> 5); scr[kk * 33 + (lane & 31)] = src[(size_t)(k0 + kk) * ldsrc + n0 + (lane & 31)]; }
    asm volatile("s_waitcnt lgkmcnt(0)" ::: "memory");
    const int c = lane & 7;
#pragma unroll
    for (int j = 0; j < 4; ++j) { const int n = (lane >> 3) + 8 * j; const LAS float* s = scr + (8 * c) * 33 + n;
        u32x4 o; o.x = pk2(s[0 * 33], s[1 * 33]); o.y = pk2(s[2 * 33], s[3 * 33]); o.z = pk2(s[4 * 33], s[5 * 33]); o.w = pk2(s[6 * 33], s[7 * 33]);
        *(u32x4*)(dstrow0 + (size_t)n * lddst + k0 + 8 * c) = o; }
    asm volatile("s_waitcnt lgkmcnt(0)" ::: "memory");
}

__device__ __forceinline__ void phase0(KArgP pk, LAS unsigned char* lds) {
    const int tid = opaque_tid(), lane = tid & 63, wave = tid >> 6, bid = opaque_bid();
    const int G = gridDim.x, gw = bid * 8 + wave, NGW = G * 8;
    unsigned char* ws = pk->ws;
    {
        const int gt = bid * 512 + tid, NT = G * 512;
        float2* rope = (float2*)(ws + WS_ROPE);
        for (int e = gt; e < 2048 * 32; e += NT) { const int pos = e >> 5, i = e & 31;
            const float inv = exp2f(-(float)(i & 15) * 0.83048202372f);
            const float ang = (float)(i < 16 ? (pos >> 6) : (pos & 63)) * inv;
            float rev = ang * 0.15915494309f; rev -= floorf(rev);
            rope[e] = make_float2(__builtin_amdgcn_cosf(rev), __builtin_amdgcn_sinf(rev)); }
        float* sp = (float*)(ws + WS_SP);
        for (int e = gt; e < 2 * 2 * 1024; e += NT) sp[e] = 8.f * log1pf(__expf(-pk->in[I_LAM][e]));
        for (int e = gt; e < 2 * 192 * 128; e += NT) { const int j = e / (192 * 128), r = e % (192 * 128);
            ((u32x4*)(ws + WS_WDQT + (size_t)j * 2 * MiB + (size_t)832 * 1024 * 2))[r] = (u32x4){0u, 0u, 0u, 0u}; }
    }
    {
        LAS float* scr = (LAS float*)(lds + wave * 16384);
        constexpr int IT_W1 = 16 * 128, IT_W2 = 64 * 32, IT_WIN = 16 * 64, IT_SQ = 16 * 32, IT_G = 8, IT_DQ = 16 * 26, IT_UQ = 8 * 48, IT_UKV = 4 * 64;
        constexpr int N1 = 4 * IT_W1, N2 = 4 * IT_W2, N3 = 2 * IT_WIN, N4 = 2 * IT_SQ, N5 = 64 * IT_G, N6 = 2 * IT_DQ, N7 = 2 * IT_UQ, N8 = 2 * IT_UKV, N9 = 2 * IT_SQ;
        constexpr int NITEMS = N1 + N2 + N3 + N4 + N5 + N6 + N7 + N8 + N9;
        for (int it = gw; it < NITEMS; it += NGW) {
            int r = it;
            if (r < N1) { const int l = r / IT_W1, q = r % IT_W1, kb = q / 128, nb = q % 128;
                transpose_item(pk->in[I_W1] + (size_t)l * 1024 * 4096, 4096, kb * 64, nb * 32, (bf16_t*)(ws + WS_W1T) + ((size_t)l * 4096 + nb * 32) * 1024, 1024, scr, lane); continue; } r -= N1;
            if (r < N2) { const int l = r / IT_W2, q = r % IT_W2, kb = q / 32, nb = q % 32;
                transpose_item(pk->in[I_W2] + (size_t)l * 4096 * 1024, 1024, kb * 64, nb * 32, (bf16_t*)(ws + WS_W2T) + ((size_t)l * 1024 + nb * 32) * 4096, 4096, scr, lane); continue; } r -= N2;
            if (r < N3) { const int j = r / IT_WIN, q = r % IT_WIN, kb = q / 64, nb = q % 64;
                transpose_item(pk->in[I_WIN] + (size_t)j * 1024 * 2048, 2048, kb * 64, nb * 32, (bf16_t*)(ws + WS_WINT) + ((size_t)j * 2048 + nb * 32) * 1024, 1024, scr, lane); continue; } r -= N3;
            if (r < N4) { const int j = r / IT_SQ, q = r % IT_SQ, kb = q / 32, nb = q % 32;
                transpose_item(pk->in[I_WOUT] + (size_t)j * 1024 * 1024, 1024, kb * 64, nb * 32, (bf16_t*)(ws + WS_WOUTT) + ((size_t)j * 1024 + nb * 32) * 1024, 1024, scr, lane); continue; } r -= N4;
            if (r < N5) { const int mat = r / IT_G, q = r % IT_G, kb = q / 4, nb = q % 4;
                const int which = mat & 1, blk = (mat >> 1) & 7, dir = (mat >> 4) & 1, j = mat >> 5;
                const float* src = (which ? pk->in[I_WX] : pk->in[I_WA]) + (size_t)(((j * 2 + dir) * 8 + blk)) * 128 * 128;
                bf16_t* dst = (bf16_t*)(ws + WS_WGT) + ((size_t)j * 4096 + (blk * 2 + dir) * 256 + which * 128 + nb * 32) * 128;
                transpose_item(src, 128, kb * 64, nb * 32, dst, 128, scr, lane); continue; } r -= N5;
            if (r < N6) { const int j = r / IT_DQ, q = r % IT_DQ, kb = q / 26, nb = q % 26;
                transpose_item(pk->in[I_WDQ] + (size_t)j * 1024 * 832, 832, kb * 64, nb * 32, (bf16_t*)(ws + WS_WDQT) + ((size_t)j * 1024 + nb * 32) * 1024, 1024, scr, lane); continue; } r -= N6;
            if (r < N7) { const int j = r / IT_UQ, q = r % IT_UQ, kb = q / 48, nb = q % 48;
                transpose_item(pk->in[I_WUQ] + (size_t)j * 512 * 1536, 1536, kb * 64, nb * 32, (bf16_t*)(ws + WS_WUQT) + ((size_t)j * 1536 + nb * 32) * 512, 512, scr, lane); continue; } r -= N7;
            if (r < N8) { const int j = r / IT_UKV, q = r % IT_UKV, kb = q / 64, nb = q % 64;
                const int n0 = nb * 32, head = n0 >> 8, within = n0 & 255;
                bf16_t* dst = within < 128 ? (bf16_t*)(ws + WS_WUKT) + ((size_t)j * 1024 + head * 128 + within) * 256
                                           : (bf16_t*)(ws + WS_WUVT) + ((size_t)j * 1024 + head * 128 + within - 128) * 256;
                transpose_item(pk->in[I_WUKV] + (size_t)j * 256 * 2048, 2048, kb * 64, n0, dst, 256, scr, lane); continue; } r -= N8;
            { const int j = r / IT_SQ, q = r % IT_SQ, kb = q / 32, nb = q % 32;
                transpose_item(pk->in[I_WO] + (size_t)j * 1024 * 1024, 1024, kb * 64, nb * 32, (bf16_t*)(ws + WS_WOT) + ((size_t)j * 1024 + nb * 32) * 1024, 1024, scr, lane); }
        }
    }
    __syncthreads();
    {
        LAS float* sl = (LAS float*)lds;
        LAS float* red = (LAS float*)(lds + 36864);
        for (int e = tid; e < 9 * 1024; e += 512) { const int cnd = e >> 10, k = e & 1023;
            const float v = cnd == 0 ? pk->in[I_CCTX][k] : pk->in[I_C][(cnd - 1) * 1024 + k]; sl[e] = v / (1.f + __expf(-v)); }
        __syncthreads();
        float* mod = (float*)(ws + WS_MOD);
        const int half = lane >> 5, l32 = lane & 31;
        for (int unit = bid; unit < 4 * 48; unit += G) {
            const int l = unit / 48, cb = unit % 48, col = cb * 128 + l32 * 4;
            const float* w = pk->in[I_ADAW] + (size_t)l * 1024 * 6144 + col;
            f32x4 acc[9];
#pragma unroll
            for (int c = 0; c < 9; ++c) acc[c] = (f32x4){0.f, 0.f, 0.f, 0.f};
            const int kbase = wave * 128 + half;
#pragma unroll 4
            for (int i = 0; i < 64; ++i) { const int k = kbase + 2 * i; const f32x4 wv = *(const f32x4*)(w + (size_t)k * 6144);
#pragma unroll
                for (int c = 0; c < 9; ++c) acc[c] += wv * sl[c * 1024 + k]; }
            const int part = wave * 2 + half;
#pragma unroll
            for (int c = 0; c < 9; ++c)
#pragma unroll
                for (int j = 0; j < 4; ++j) red[(part * 36 + c * 4 + j) * 32 + l32] = acc[c][j];
            __syncthreads();
            for (int o = tid; o < 9 * 128; o += 512) { const int c = o >> 7, cc = o & 127, ll = cc >> 2, j = cc & 3; float s = 0.f;
#pragma unroll
                for (int pp = 0; pp < 16; ++pp) s += red[(pp * 36 + c * 4 + j) * 32 + ll];
                mod[((size_t)l * 9 + c) * 6144 + cb * 128 + cc] = s + pk->in[I_ADAB][l * 6144 + cb * 128 + cc]; }
            __syncthreads();
        }
    }
}

__device__ __forceinline__ void norm_phase(const float* x0, const float* x1, const float* gn, const float* modl, int iscale, bf16_t* H, float* ss) {
    const int tid_ = opaque_tid(), lane = tid_ & 63, gw = opaque_bid() * 8 + (tid_ >> 6), NGW = gridDim.x * 8;
    f32x4 nv[4];
    if (gw < M) { const float* xr = gw < MCTX ? x0 + (size_t)gw * D : x1 + (size_t)(gw - MCTX) * D;
#pragma unroll
        for (int j = 0; j < 4; ++j) nv[j] = *(const f32x4*)(xr + 4 * lane + 256 * j); }
    for (int row = gw; row < M; row += NGW) {
        const int cnd = row < MCTX ? 0 : 1 + ((row - MCTX) >> 11);
        const float* sc = modl + (size_t)cnd * 6144 + iscale * 1024;
        f32x4 v[4]; float sq = 0.f;
#pragma unroll
        for (int j = 0; j < 4; ++j) v[j] = nv[j];
        const int rn = row + NGW;
        if (rn < M) { const float* xr = rn < MCTX ? x0 + (size_t)rn * D : x1 + (size_t)(rn - MCTX) * D;
#pragma unroll
            for (int j = 0; j < 4; ++j) nv[j] = *(const f32x4*)(xr + 4 * lane + 256 * j); }
#pragma unroll
        for (int j = 0; j < 4; ++j) sq += (v[j][0] * v[j][0] + v[j][1] * v[j][1]) + (v[j][2] * v[j][2] + v[j][3] * v[j][3]);
        sq = wave_sum(sq, lane);
        if (lane < 16) ss[(size_t)row * 16 + lane] = lane == 0 ? sq : 0.f;
#pragma unroll
        for (int j = 0; j < 4; ++j) { const int c = 4 * lane + 256 * j;
            const f32x4 g = *(const f32x4*)(gn + c), s_ = *(const f32x4*)(sc + c);
            const f32x4 y = v[j] * g * (s_ + 1.f);
            *(u32x2*)(H + (size_t)row * D + c) = (u32x2){pk2(y[0], y[1]), pk2(y[2], y[3])}; }
    }
}
__device__ __forceinline__ void final_norm_phase(float* X, const float* gn) {
    const int tid_ = opaque_tid(), lane = tid_ & 63, gw = opaque_bid() * 8 + (tid_ >> 6), NGW = gridDim.x * 8;
    f32x4 g[4];
#pragma unroll
    for (int j = 0; j < 4; ++j) g[j] = *(const f32x4*)(gn + 4 * lane + 256 * j);
    f32x4 nv[4];
    if (gw < M) {
#pragma unroll
        for (int j = 0; j < 4; ++j) nv[j] = *(const f32x4*)(X + (size_t)gw * D + 4 * lane + 256 * j); }
    for (int row = gw; row < M; row += NGW) {
        float* xr = X + (size_t)row * D;
        f32x4 v[4]; float ss = 0.f;
#pragma unroll
        for (int j = 0; j < 4; ++j) v[j] = nv[j];
        if (row + NGW < M) {
#pragma unroll
            for (int j = 0; j < 4; ++j) nv[j] = *(const f32x4*)(xr + (size_t)NGW * D + 4 * lane + 256 * j); }
#pragma unroll
        for (int j = 0; j < 4; ++j) ss += (v[j][0] * v[j][0] + v[j][1] * v[j][1]) + (v[j][2] * v[j][2] + v[j][3] * v[j][3]);
        const float rstd = rsqrtf(wave_sum(ss, lane) * (1.f / D) + 1e-6f);
#pragma unroll
        for (int j = 0; j < 4; ++j) *(f32x4*)(xr + 4 * lane + 256 * j) = v[j] * rstd * g[j];
    }
}
__device__ __forceinline__ void conv_phase(const bf16_t* XB, bf16_t* XC, const float* cw, const float* cb) {
    const int gt = opaque_bid() * 512 + opaque_tid(), NT = gridDim.x * 512;
    for (int it = gt; it < (M / 8) * 128; it += NT) {
        const int tg = it >> 7, cgp = it & 127, ch0 = cgp * 8, r0 = tg * 8;
        const int seqlen = r0 < MCTX ? 256 : 2048; const int t0 = r0 < MCTX ? (r0 & 255) : ((r0 - MCTX) & 2047);
        float w[4][8], bias[8];
#pragma unroll
        for (int k = 0; k < 4; ++k)
#pragma unroll
            for (int j = 0; j < 8; ++j) w[k][j] = cw[k * 1024 + ch0 + j];
#pragma unroll
        for (int j = 0; j < 8; ++j) bias[j] = cb[ch0 + j];
        float acc[8][8];
#pragma unroll
        for (int t = 0; t < 8; ++t)
#pragma unroll
            for (int j = 0; j < 8; ++j) acc[t][j] = bias[j];
#pragma unroll
        for (int s = 0; s < 11; ++s) {
            const int ts = t0 - 1 + s;
            u32x4 xw = (u32x4){0u, 0u, 0u, 0u};
            if (ts >= 0 && ts < seqlen) xw = *(const u32x4*)(XB + (size_t)(r0 - 1 + s) * 1024 + ch0);
            const float xf[8] = {bflo(xw.x), bfhi(xw.x), bflo(xw.y), bfhi(xw.y), bflo(xw.z), bfhi(xw.z), bflo(xw.w), bfhi(xw.w)};
#pragma unroll
            for (int k = 0; k < 4; ++k) { const int t = s - k;
                if (t >= 0 && t < 8) {
#pragma unroll
                    for (int j = 0; j < 8; ++j) acc[t][j] += w[k][j] * xf[j]; } }
        }
#pragma unroll
        for (int t = 0; t < 8; ++t)
            *(u32x4*)(XC + (size_t)(r0 + t) * 1024 + ch0) = (u32x4){pk2(acc[t][0], acc[t][1]), pk2(acc[t][2], acc[t][3]), pk2(acc[t][4], acc[t][5]), pk2(acc[t][6], acc[t][7])};
    }
}
__device__ __forceinline__ void scan1_phase(const unsigned* AB, float* car) {
    const int gt = opaque_bid() * 512 + opaque_tid(), NT = gridDim.x * 512;
    for (int it = gt; it < 2 * 640 * 256; it += NT) {
        const int cg4 = it & 255, c = (it >> 8) % 640, dir = it / (640 * 256);
        const unsigned* ab = AB + ((size_t)dir * M + c * 32) * 1024 + cg4 * 4;
        u32x4 v[32];
#pragma unroll
        for (int s = 0; s < 32; ++s) v[s] = *(const u32x4*)(ab + (size_t)s * 1024);
        asm volatile("" ::: "memory");
        float sl[4] = {0.f, 0.f, 0.f, 0.f}, h[4] = {0.f, 0.f, 0.f, 0.f};
        if (dir == 0) {
#pragma unroll
            for (int s = 0; s < 32; ++s) { const unsigned vv[4] = {v[s].x, v[s].y, v[s].z, v[s].w};
#pragma unroll
                for (int j = 0; j < 4; ++j) { const float la = bflo(vv[j]), b = bfhi(vv[j]); h[j] = __expf(la) * h[j] + b; sl[j] += la; } }
        } else {
#pragma unroll
            for (int s = 31; s >= 0; --s) { const unsigned vv[4] = {v[s].x, v[s].y, v[s].z, v[s].w};
#pragma unroll
                for (int j = 0; j < 4; ++j) { const float la = bflo(vv[j]), b = bfhi(vv[j]); h[j] = __expf(la) * h[j] + b; sl[j] += la; } }
        }
        float* o = car + (((size_t)dir * 640 + c) * 1024 + cg4 * 4) * 2;
        *(f32x4*)o = (f32x4){sl[0], h[0], sl[1], h[1]}; *(f32x4*)(o + 4) = (f32x4){sl[2], h[2], sl[3], h[3]};
    }
}
__device__ __forceinline__ void scan2_phase(float* car, const float* state_in  , int j, float* out_state) {
    const int gt = opaque_bid() * 512 + opaque_tid(), NT = gridDim.x * 512;
    for (int it = gt; it < 2 * 24 * 1024; it += NT) {
        const int ch = it & 1023, seq = (it >> 10) % 24, dir = it / (24 * 1024);
        const int c0 = seq < 16 ? seq * 8 : 128 + (seq - 16) * 64, nc = seq < 16 ? 8 : 64;
        float h = seq < 16 ? 0.f : state_in[(((size_t)(seq - 16) * 2 + j) * 2 + dir) * 1024 + ch];
        float2* cp = (float2*)car + ((size_t)dir * 640 + c0) * 1024 + ch;
#pragma unroll 8
        for (int s = 0; s < nc; ++s) { const int c = dir ? nc - 1 - s : s; const float2 v = cp[(size_t)c * 1024];
            cp[(size_t)c * 1024].y = h; h = __expf(v.x) * h + v.y; }
        if (seq < 16) out_state[(((size_t)seq * 2 + j) * 2 + dir) * 1024 + ch] = h;
    }
}
__device__ __forceinline__ void scan3_phase(const unsigned* AB, const float* car, const bf16_t* YB, bf16_t* Gout) {
    const int gt = opaque_bid() * 512 + opaque_tid(), NT = gridDim.x * 512;
    for (int it = gt; it < 640 * 512; it += NT) {
        const int cp = it & 511, c = it >> 9, ch = cp * 2;
        const size_t rb = (size_t)c * 32 * 1024 + ch;
        u32x2 vf[32], vb[32]; unsigned yv[32];
        const f32x4 cif = *(const f32x4*)(car + (((size_t)0 * 640 + c) * 1024 + ch) * 2), cib = *(const f32x4*)(car + (((size_t)1 * 640 + c) * 1024 + ch) * 2);
#pragma unroll
        for (int t = 0; t < 32; ++t) vf[t] = *(const u32x2*)(AB + rb + (size_t)t * 1024);
#pragma unroll
        for (int t = 0; t < 32; ++t) vb[t] = *(const u32x2*)(AB + (size_t)M * 1024 + rb + (size_t)t * 1024);
#pragma unroll
        for (int t = 0; t < 32; ++t) yv[t] = *(const unsigned*)(YB + rb + (size_t)t * 1024);
        asm volatile("" ::: "memory");
        float hf[32][2];
        { float h0 = cif[1], h1 = cif[3];
#pragma unroll
          for (int t = 0; t < 32; ++t) { h0 = __expf(bflo(vf[t].x)) * h0 + bfhi(vf[t].x); h1 = __expf(bflo(vf[t].y)) * h1 + bfhi(vf[t].y); hf[t][0] = h0; hf[t][1] = h1; } }
        { float h0 = cib[1], h1 = cib[3];
#pragma unroll
          for (int t = 31; t >= 0; --t) { h0 = __expf(bflo(vb[t].x)) * h0 + bfhi(vb[t].x); h1 = __expf(bflo(vb[t].y)) * h1 + bfhi(vb[t].y);
              *(unsigned*)(Gout + rb + (size_t)t * 1024) = pk2((hf[t][0] + h0) * bflo(yv[t]), (hf[t][1] + h1) * bfhi(yv[t])); } }
    }
}
__device__ __forceinline__ int kvrow_of(int row) { return row < MCTX ? row : MCTX + ((row - MCTX) >> 11) * KVB + ((row - MCTX) & 2047); }
__device__ __forceinline__ void mla_post_phase(const float* PROJ, const float* gq, const float* gkv, const float* rope, const float* cckv, const float* ckpe, int j,
                                               bf16_t* CQ, bf16_t* CKV, bf16_t* KPE, float* out_ckv, float* out_kpe) {
    const int tid_ = opaque_tid(), lane = tid_ & 63, gw = opaque_bid() * 8 + (tid_ >> 6), NGW = gridDim.x * 8;
    for (int row = gw; row < M + 2048; row += NGW) {
        if (row < M) {
            const float* pr = PROJ + (size_t)row * 1024;
            const f32x4 a = *(const f32x4*)(pr + 4 * lane), b = *(const f32x4*)(pr + 256 + 4 * lane), cv = *(const f32x4*)(pr + 512 + 4 * lane);
            const float ssq = wave_sum((a[0] * a[0] + a[1] * a[1]) + (a[2] * a[2] + a[3] * a[3]) + (b[0] * b[0] + b[1] * b[1]) + (b[2] * b[2] + b[3] * b[3]), lane);
            const float ssk = wave_sum((cv[0] * cv[0] + cv[1] * cv[1]) + (cv[2] * cv[2] + cv[3] * cv[3]), lane);
            const float rq = rsqrtf(ssq * (1.f / 512.f) + 1e-6f), rk = rsqrtf(ssk * (1.f / 256.f) + 1e-6f);
            const f32x4 ga = *(const f32x4*)(gq + 4 * lane), gb = *(const f32x4*)(gq + 256 + 4 * lane), gk = *(const f32x4*)(gkv + 4 * lane);
            const f32x4 ya = a * rq * ga, yb = b * rq * gb, yk = cv * rk * gk;
            *(u32x2*)(CQ + (size_t)row * 512 + 4 * lane) = (u32x2){pk2(ya[0], ya[1]), pk2(ya[2], ya[3])};
            *(u32x2*)(CQ + (size_t)row * 512 + 256 + 4 * lane) = (u32x2){pk2(yb[0], yb[1]), pk2(yb[2], yb[3])};
            const int kr = kvrow_of(row);
            *(u32x2*)(CKV + (size_t)kr * 256 + 4 * lane) = (u32x2){pk2(yk[0], yk[1]), pk2(yk[2], yk[3])};
            if (row < MCTX) { const int bb = row >> 8, t = row & 255; *(f32x4*)(out_ckv + (((size_t)bb * 2 + j) * 256 + t) * 256 + 4 * lane) = yk; }
            if (lane < 32) { const f32x2 kp = *(const f32x2*)(pr + 768 + 2 * lane); float x1 = kp[0], x2 = kp[1];
                if (row < MCTX) { const int bb = row >> 8, t = row & 255; *(f32x2*)(out_kpe + (((size_t)bb * 2 + j) * 256 + t) * 64 + 2 * lane) = kp; }
                else { const int pos = (row - MCTX) & 2047; const f32x2 cs = *(const f32x2*)(rope + ((size_t)pos * 32 + lane) * 2);
                    const float o1 = x1 * cs[0] - x2 * cs[1], o2 = x1 * cs[1] + x2 * cs[0]; x1 = o1; x2 = o2; }
                *(unsigned*)(KPE + (size_t)kr * 64 + 2 * lane) = pk2(x1, x2); }
        } else {
            const int cr = row - M, bb = cr >> 8, s = cr & 255, kr = MCTX + bb * KVB + 2048 + s;
            const f32x4 cv = *(const f32x4*)(cckv + (((size_t)bb * 2 + j) * 256 + s) * 256 + 4 * lane);
            *(u32x2*)(CKV + (size_t)kr * 256 + 4 * lane) = (u32x2){pk2(cv[0], cv[1]), pk2(cv[2], cv[3])};
            if (lane < 32) { const f32x2 kp = *(const f32x2*)(ckpe + (((size_t)bb * 2 + j) * 256 + s) * 64 + 2 * lane);
                *(unsigned*)(KPE + (size_t)kr * 64 + 2 * lane) = pk2(kp[0], kp[1]); }
        }
    }
}

constexpr int AT_PE = 16384, AT_VT = 24576, ATT_BUF = 40960;
__device__ __forceinline__ void attn_phase(LAS unsigned char* lds, const bf16_t* Q, const bf16_t* KN, const bf16_t* KPE, const bf16_t* VT, bf16_t* O) {
    const int tid = opaque_tid(), lane = tid & 63, wave = __builtin_amdgcn_readfirstlane(tid >> 6), q32 = lane & 31, hi = lane >> 5;
    const int G = gridDim.x, bx = opaque_bid();
    const int xcd = bx & 7, idx = bx >> 3;
    const int pi_row = 16 * ((q32 >> 3) >> 1) + 8 * ((q32 >> 2) & 1) + 4 * ((q32 >> 3) & 1) + (q32 & 3);
    const unsigned laneN = (unsigned)(pi_row * 256 + (((pi_row & 15) ^ hi) * 16));
    const unsigned laneP = (unsigned)(AT_PE + pi_row * 128 + ((((pi_row >> 1) & 7) ^ hi) * 16));
    const unsigned laneV = (unsigned)(AT_VT + q32 * 128 + ((((q32 >> 1) & 7) ^ hi) * 16));
    const int rN = 8 * wave + (lane >> 4), cN = (lane & 15) ^ (rN & 15);
    const unsigned oN0 = (unsigned)(rN * 1024 + cN * 8) * 2u, oN1 = (unsigned)((rN + 4) * 1024 + (cN ^ 4) * 8) * 2u;
    const int rP = 8 * wave + (lane >> 3), cP = (lane & 7) ^ ((rP >> 1) & 7);
    const unsigned oP = (unsigned)(rP * 64 + cP * 8) * 2u;
    const int dV = 16 * wave + (lane >> 3), cV = (lane & 7) ^ ((dV >> 1) & 7);
    const unsigned oV0 = (unsigned)(dV * MKV + cV * 8) * 2u, oV1 = (unsigned)((dV + 8) * MKV + (cV ^ 4) * 8) * 2u;
    for (int ui = bx; ui < 512 + 128; ui += G) {
        int qrow0, kv0, ntile, h;
        if (ui < 512) {
            int bh, qb;
            if (G == 256) { const int r = ui >> 8; bh = r * 32 + xcd * 4 + (idx >> 3); qb = idx & 7; } else { bh = ui >> 3; qb = ui & 7; }
            const int b = bh >> 3; h = bh & 7; qrow0 = MCTX + b * 2048 + qb * 256; kv0 = MCTX + b * KVB; ntile = 36;
        } else { const int v = ui - 512, b = v >> 3; h = v & 7; qrow0 = b * 256; kv0 = b * 256; ntile = 4; }
        bf16x8 qf[12];
        { const char* qb_ = (const char*)(Q + (size_t)(qrow0 + wave * 32) * QW + h * 192); const unsigned qo_ = (unsigned)(q32 * QW + 8 * hi) * 2u;
#pragma unroll
          for (int ks = 0; ks < 12; ++ks) qf[ks] = *(const bf16x8*)(qb_ + 32 * ks + qo_); }
        f32x16 oacc[4];
#pragma unroll
        for (int d = 0; d < 4; ++d)
#pragma unroll
            for (int r = 0; r < 16; ++r) oacc[d][r] = 0.f;
        float m_run = -1e30f, l_run = 0.f;
        const char* bKn = (const char*)(KN + (size_t)kv0 * 1024 + h * 128);
        const char* bKp = (const char*)(KPE + (size_t)kv0 * 64);
        const char* bV = (const char*)(VT + (size_t)(h * 128) * MKV + kv0);
#define ATT_GLDS(g, l) __builtin_amdgcn_global_load_lds((const unsigned*)(g), (LAS unsigned*)(l), 16, 0, 0)
#define ATT_DMA(t, bufb) do { const char* k_ = bKn + (size_t)(t) * (64 * 1024 * 2); const char* p_ = bKp + (size_t)(t) * (64 * 64 * 2); const char* v_ = bV + (size_t)(t) * 128; \
        LAS unsigned char* d_ = lds + (bufb); \
        ATT_GLDS(k_ + oN0, d_ + (2 * wave) * 1024); ATT_GLDS(k_ + oN1, d_ + (2 * wave + 1) * 1024); ATT_GLDS(p_ + oP, d_ + AT_PE + wave * 1024); \
        ATT_GLDS(v_ + oV0, d_ + AT_VT + (2 * wave) * 1024); ATT_GLDS(v_ + oV1, d_ + AT_VT + (2 * wave + 1) * 1024); } while (0)
        asm volatile("s_waitcnt lgkmcnt(0)" ::: "memory"); __builtin_amdgcn_s_barrier(); asm volatile("" ::: "memory");
        ATT_DMA(0, 0); ATT_DMA(1, ATT_BUF);
        int bcur = 0;
        for (int t = 0; t < ntile; ++t) {
            if (t + 1 < ntile) asm volatile("s_waitcnt vmcnt(5)" ::: "memory"); else asm volatile("s_waitcnt vmcnt(0)" ::: "memory");
            asm volatile("s_waitcnt lgkmcnt(0)" ::: "memory"); __builtin_amdgcn_s_barrier(); asm volatile("" ::: "memory");
            const int bprev = bcur == 0 ? 2 * ATT_BUF : bcur - ATT_BUF;
            if (t + 2 < ntile) ATT_DMA(t + 2, bprev);
            const unsigned aN = laneN + (unsigned)bcur, aP = laneP + (unsigned)bcur, aV = laneV + (unsigned)bcur;
            bcur = bcur == 2 * ATT_BUF ? 0 : bcur + ATT_BUF;
            f32x16 s0, s1;
#pragma unroll
            for (int r = 0; r < 16; ++r) { s0[r] = 0.f; s1[r] = 0.f; }
#pragma unroll
            for (int ks = 0; ks < 12; ++ks) {
                const unsigned pa = ks < 8 ? (aN ^ (unsigned)(ks * 32)) : (aP ^ (unsigned)((ks - 8) * 32));
                const bf16x8 a0 = *(const LAS bf16x8*)(lds + pa), a1 = *(const LAS bf16x8*)(lds + pa + (ks < 8 ? 8192 : 4096));
                s0 = __builtin_amdgcn_mfma_f32_32x32x16_bf16(a0, qf[ks], s0, 0, 0, 0);
                s1 = __builtin_amdgcn_mfma_f32_32x32x16_bf16(a1, qf[ks], s1, 0, 0, 0);
            }
            float mx = s0[0];
#pragma unroll
            for (int r = 1; r < 16; ++r) mx = fmaxf(mx, s0[r]);
#pragma unroll
            for (int r = 0; r < 16; ++r) mx = fmaxf(mx, s1[r]);
            mx = fmaxf(mx, shfl_xor_l(mx, lane, 32));
            const float m_new = fmaxf(m_run, mx), alpha = __builtin_amdgcn_exp2f(m_run - m_new);
            const bool grow = __builtin_amdgcn_ballot_w64(m_new > m_run) != 0ull; m_run = m_new;
            float ls = 0.f;
#pragma unroll
            for (int r = 0; r < 16; ++r) { s0[r] = __builtin_amdgcn_exp2f(s0[r] - m_new); s1[r] = __builtin_amdgcn_exp2f(s1[r] - m_new); ls += s0[r] + s1[r]; }
            l_run = l_run * alpha + ls;
            if (grow) {
#pragma unroll
                for (int d = 0; d < 4; ++d)
#pragma unroll
                    for (int r = 0; r < 16; ++r) oacc[d][r] *= alpha;
            }
            bf16x8 pb[2][2];
#pragma unroll
            for (int jj = 0; jj < 2; ++jj) {
                u32x4 w0, w1;
                w0.x = pg8::cvt_pk_bf16(s0[8 * jj + 0], s0[8 * jj + 1]); w0.y = pg8::cvt_pk_bf16(s0[8 * jj + 2], s0[8 * jj + 3]);
                w0.z = pg8::cvt_pk_bf16(s0[8 * jj + 4], s0[8 * jj + 5]); w0.w = pg8::cvt_pk_bf16(s0[8 * jj + 6], s0[8 * jj + 7]);
                w1.x = pg8::cvt_pk_bf16(s1[8 * jj + 0], s1[8 * jj + 1]); w1.y = pg8::cvt_pk_bf16(s1[8 * jj + 2], s1[8 * jj + 3]);
                w1.z = pg8::cvt_pk_bf16(s1[8 * jj + 4], s1[8 * jj + 5]); w1.w = pg8::cvt_pk_bf16(s1[8 * jj + 6], s1[8 * jj + 7]);
                pb[0][jj] = __builtin_bit_cast(bf16x8, w0); pb[1][jj] = __builtin_bit_cast(bf16x8, w1);
            }
#pragma unroll
            for (int hf = 0; hf < 2; ++hf)
#pragma unroll
                for (int jj = 0; jj < 2; ++jj) {
                    const unsigned pv = aV ^ (unsigned)(hf * 64 + jj * 32);
#pragma unroll
                    for (int d = 0; d < 4; ++d) {
                        const bf16x8 av = *(const LAS bf16x8*)(lds + pv + d * 4096);
                        oacc[d] = __builtin_amdgcn_mfma_f32_32x32x16_bf16(av, pb[hf][jj], oacc[d], 0, 0, 0);
                    }
                }
        }
        const float lt = l_run + shfl_xor_l(l_run, lane, 32), inv = 1.f / lt;
        char* ob_ = (char*)(O + (size_t)(qrow0 + wave * 32) * 1024 + h * 128); const unsigned oo_ = (unsigned)(q32 * 1024 + 4 * hi) * 2u;
#pragma unroll
        for (int d = 0; d < 4; ++d)
#pragma unroll
            for (int g4 = 0; g4 < 4; ++g4)
                *(u32x2*)(ob_ + (d * 32 + g4 * 8) * 2 + oo_) = (u32x2){pk2(oacc[d][4 * g4 + 0] * inv, oacc[d][4 * g4 + 1] * inv), pk2(oacc[d][4 * g4 + 2] * inv, oacc[d][4 * g4 + 3] * inv)};
#undef ATT_GLDS
#undef ATT_DMA
    }
    asm volatile("s_waitcnt vmcnt(0) lgkmcnt(0)" ::: "memory"); __builtin_amdgcn_s_barrier(); asm volatile("" ::: "memory");
}

#define XB_TMO      128
#define XB_XCNT(j)  (256  + 64 * (j))
#define XB_XSUB(j)  (1280 + 64 * (j))
#define XB_XGEN(j)  (2304 + 64 * (j))
#define XB_TOP      3328
#define XB_TOPGEN   3392
#define XCD_BAR_WORDS 3456
#define XB_SPIN_CAP (1u << 22)
__device__ __forceinline__ unsigned xb_ld(unsigned* p)              { return __hip_atomic_load(p, __ATOMIC_RELAXED, __HIP_MEMORY_SCOPE_AGENT); }
__device__ __forceinline__ unsigned xb_add(unsigned* p, unsigned v) { return __hip_atomic_fetch_add(p, v, __ATOMIC_RELAXED, __HIP_MEMORY_SCOPE_AGENT); }
__device__ __forceinline__ unsigned xb_xcc_id() { return (unsigned)__builtin_amdgcn_s_getreg((3 << 11) | 20) & 0xFu; }
#define XB_SPIN(cond, bar) do { unsigned _sp = 0; while (cond) { __builtin_amdgcn_s_sleep(1); \
    if ((++_sp & 255u) == 0u) { if (xb_ld(&(bar)[XB_TMO])) break; if (_sp > XB_SPIN_CAP) { atomicAdd(&(bar)[XB_TMO], 1u); break; } } } } while (0)
struct XcdBarrier { unsigned* bar; unsigned x; volatile LAS unsigned* st; };
__device__ __forceinline__ XcdBarrier xcd_barrier_post(unsigned* bar, volatile LAS unsigned* st) {
    XcdBarrier b; b.bar = bar; b.x = xb_xcc_id(); b.st = st;
    if (threadIdx.x == 0) (void)xb_add(&bar[XB_XCNT(b.x)], 1u);
    return b;
}
__device__ __forceinline__ void xcd_barrier_complete(unsigned* bar, unsigned x, unsigned& nloc, unsigned& nx) {
    const unsigned G = gridDim.x * gridDim.y * gridDim.z;
    unsigned sum, cnt, mine, sp = 0u;
    for (;;) {
        sum = 0u; cnt = 0u; mine = 0u;
#pragma unroll
        for (unsigned j = 0; j < 16; ++j) { const unsigned c = xb_ld(&bar[XB_XCNT(j)]); sum += c; cnt += (c > 0u) ? 1u : 0u; mine = (j == x) ? c : mine; }
        if (sum == G) break;
        __builtin_amdgcn_s_sleep(1);
        if ((++sp & 255u) == 0u) { if (xb_ld(&bar[XB_TMO])) break; if (sp > XB_SPIN_CAP) { atomicAdd(&bar[XB_TMO], 1u); break; } }
    }
    nloc = mine > 0u ? mine : 1u; nx = cnt > 0u ? cnt : 1u;
}
__device__ __forceinline__ void xcd_barrier(const XcdBarrier& b) {
    asm volatile("s_waitcnt vmcnt(0)" ::: "memory");
    __syncthreads();
    if (threadIdx.x == 0) {
        unsigned* bar = b.bar;
        __builtin_amdgcn_s_waitcnt(0);
        unsigned nloc = b.st[0], nx = b.st[1];
        if (nloc == 0u) { xcd_barrier_complete(bar, b.x, nloc, nx); b.st[0] = nloc; b.st[1] = nx; }
        const unsigned old = xb_add(&bar[XB_XSUB(b.x)], 1u);
        const unsigned gen = old / nloc;
        if (old + 1u == (gen + 1u) * nloc) {
            __builtin_amdgcn_fence(__ATOMIC_RELEASE, "agent");
            asm volatile("s_waitcnt vmcnt(0)" ::: "memory");
            const unsigned og = xb_add(&bar[XB_TOP], 1u);
            const unsigned tg = og / nx;
            if (og + 1u == (tg + 1u) * nx) xb_add(&bar[XB_TOPGEN], 1u);
            else XB_SPIN(xb_ld(&bar[XB_TOPGEN]) == tg, bar);
            __builtin_amdgcn_fence(__ATOMIC_ACQUIRE, "agent");
            xb_add(&bar[XB_XGEN(b.x)], 1u);
            asm volatile("s_waitcnt vmcnt(0)" ::: "memory");
        } else {
            XB_SPIN(xb_ld(&bar[XB_XGEN(b.x)]) == gen, bar);
            __builtin_amdgcn_fence(__ATOMIC_ACQUIRE, "agent");
            asm volatile("s_waitcnt vmcnt(0)" ::: "memory");
        }
    }
    __syncthreads();
}

constexpr int N_PHASES = 39;
__global__ void __launch_bounds__(512, 2) fwd_kernel(Params p) {
    extern __shared__ __attribute__((aligned(16))) unsigned char lds_raw[];
    LAS unsigned char* lds = (LAS unsigned char*)lds_raw;
    cg::grid_group grid = cg::this_grid();
    const int lo = p.ph_lo, hi = p.ph_hi;
    int k = 0, l = 0;
    if (threadIdx.x < 16) ((LAS unsigned*)(lds + 131072))[threadIdx.x] = 0u;
    __syncthreads();
    XcdBarrier xbar = xcd_barrier_post((unsigned*)(p.ws + WS_BAR), (volatile LAS unsigned*)(lds + 131072));
#ifndef EN_MASK
#define EN_MASK 0xFFFFFFFFu
#endif
#define PH_BEGIN(id) if (((EN_MASK >> (id)) & 1u) && k >= lo && k < hi) { KArgP q = opaque_kernarg(); unsigned char* ws = q->ws; float* X = q->out; \
        const int j = l >> 1; const float* modl = (const float*)(ws + WS_MOD) + (size_t)l * 9 * 6144; const float* rope = (const float*)(ws + WS_ROPE); bf16_t* H = (bf16_t*)(ws + WS_H); \
        const float* xb0 = l == 0 ? q->in[I_XP] : X; const float* xb1 = l == 0 ? q->in[I_XS] : X + (size_t)MCTX * D; \
        bf16_t* XB = (bf16_t*)(ws + S_XB); bf16_t* YB = (bf16_t*)(ws + S_YB); bf16_t* XC = (bf16_t*)(ws + S_XC); unsigned* AB = (unsigned*)(ws + S_AB); float* car = (float*)(ws + S_CAR); \
        float* PROJ = (float*)(ws + S_PROJ); bf16_t* CQ = (bf16_t*)(ws + S_CQ); bf16_t* CKV = (bf16_t*)(ws + S_CKV); bf16_t* KPE = (bf16_t*)(ws + S_KPE); \
        bf16_t* Qb = (bf16_t*)(ws + S_Q); bf16_t* KN = (bf16_t*)(ws + S_KN); bf16_t* VT = (bf16_t*)(ws + S_VT); bf16_t* A2 = (bf16_t*)(ws + S_A2); \
        float* SS = (float*)(ws + WS_SS); const float* SWl = (const float*)(ws + WS_SW) + (size_t)l * 9 * 6144; bf16_t* OB = (bf16_t*)(ws + S_O); LAS float* RS = (LAS float*)(lds + 131072); (void)SS; (void)SWl; (void)OB; (void)RS; \
        (void)j; (void)modl; (void)rope; (void)H; (void)xb0; (void)xb1; (void)XB; (void)YB; (void)XC; (void)AB; (void)car; (void)PROJ; (void)CQ; (void)CKV; (void)KPE; (void)Qb; (void)KN; (void)VT; (void)A2; (void)X;
#define PH_END   if (k + 1 < hi) { if (hi < 0) grid.sync();   xcd_barrier(xbar); } } ++k;

    PH_BEGIN(0) phase0(q, lds); PH_END

    for (l = 0; l < 4; ++l) {
        if (l == 0) { PH_BEGIN(1) norm_phase(xb0, xb1, q->in[I_NMIX], modl, 1, H, SS); sw_phase((const float*)(ws + WS_MOD), ws, (float*)(ws + WS_SW)); PH_END }
        if ((l & 1) == 0) {
            PH_BEGIN(2) { EpiBf16<2, true> E{XB, YB, 1024, SS, SWl}; run_gemm(lds, H, 1024, (const bf16_t*)(ws + WS_WINT) + (size_t)j * 2048 * 1024, 1024, M, 2048, 1024, 0, 0, E); } PH_END
            PH_BEGIN(3) conv_phase(XB, XC, q->in[I_CONVW] + j * 4096, q->in[I_CONVB] + j * 1024); PH_END
            PH_BEGIN(4) { EpiGates E{XC, AB, q->in[I_BA] + j * 2048, q->in[I_BX] + j * 2048, (const float*)(ws + WS_SP) + j * 2048};
                       run_gemm(lds, XC, 1024, (const bf16_t*)(ws + WS_WGT) + (size_t)j * 4096 * 128, 128, M, 4096, 128, 1, 256, E); } PH_END
            PH_BEGIN(5) scan1_phase(AB, car); PH_END
            PH_BEGIN(6) scan2_phase(car, q->in[I_STATE], j, X + OUT_STATE); PH_END
            PH_BEGIN(7) scan3_phase(AB, car, YB, YB); PH_END
            PH_BEGIN(8) { EpiResid E{xb0, xb1, X, modl + 2 * 1024, H, q->in[I_NMLP] + l * 1024, modl + 4 * 1024, SS};
                       run_gemm(lds, YB, 1024, (const bf16_t*)(ws + WS_WOUTT) + (size_t)j * 1024 * 1024, 1024, M, 1024, 1024, 0, 0, E); } PH_END
        } else {
            PH_BEGIN(9) { EpiF32 E{PROJ, 1024, SS, SWl}; run_gemm(lds, H, 1024, (const bf16_t*)(ws + WS_WDQT) + (size_t)j * 1024 * 1024, 1024, M, 1024, 1024, 0, 0, E); } PH_END
            PH_BEGIN(10) mla_post_phase(PROJ, q->in[I_NQ] + j * 512, q->in[I_NKV] + j * 256, rope, q->in[I_CCKV], q->in[I_CKPE], j, CQ, CKV, KPE, X + OUT_CKV, X + OUT_KPE); PH_END
            PH_BEGIN(11) { EpiQ EQ{Qb, rope, 0.07216878364870322f * 1.4426950408889634f};
                       run_gemm(lds, CQ, 512, (const bf16_t*)(ws + WS_WUQT) + (size_t)j * 1536 * 512, 512, M, 1536, 512, 0, 0, EQ);
                       EpiBf16<0> EK{KN, nullptr, 1024, nullptr, nullptr};
                       run_gemm(lds, CKV, 256, (const bf16_t*)(ws + WS_WUKT) + (size_t)j * 1024 * 256, 256, MKV, 1024, 256, 0, 0, EK);
                       EpiBf16<0> EV{VT, nullptr, MKV, nullptr, nullptr};
                       run_gemm(lds, (const bf16_t*)(ws + WS_WUVT) + (size_t)j * 1024 * 256, 256, CKV, 256, 1024, MKV, 256, 0, 0, EV); } PH_END
            PH_BEGIN(12) attn_phase(lds, Qb, KN, KPE, VT, OB); PH_END
            PH_BEGIN(13) { EpiResid E{xb0, xb1, X, modl + 2 * 1024, H, q->in[I_NMLP] + l * 1024, modl + 4 * 1024, SS};
                       run_gemm(lds, OB, 1024, (const bf16_t*)(ws + WS_WOT) + (size_t)j * 1024 * 1024, 1024, M, 1024, 1024, 0, 0, E); } PH_END
        }
        PH_BEGIN(15) { EpiBf16<1, true> E{A2, nullptr, 4096, SS, SWl + 2048}; run_gemm(lds, H, 1024, (const bf16_t*)(ws + WS_W1T) + (size_t)l * 4096 * 1024, 1024, M, 4096, 1024, 0, 0, E); } PH_END
        PH_BEGIN(16) { const int G_ = (int)gridDim.x; const bool split = (G_ == 256);
                       EpiResid E{X, X + (size_t)MCTX * D, X, modl + 5 * 1024, l < 3 ? H : nullptr, q->in[I_NMIX] + (l + 1) * 1024, modl + 9 * 6144 + 1024, SS};
                       const bf16_t* W2 = (const bf16_t*)(ws + WS_W2T) + (size_t)l * 1024 * 4096;
                       run_gemm(lds, A2, 4096, W2, 4096, M, 1024, 4096, 0, 0, E, split ? 256 : (1 << 30));
                       if (split) { EpiPartial EP{(float*)(ws + S_PART), 256, 80, 4}; run_gemm_split(lds, A2, 4096, W2, 4096, M, 1024, 1024, 256, EP); } } PH_END
        PH_BEGIN(17) { if ((int)gridDim.x == 256) split_reduce_phase((const float*)(ws + S_PART), X, modl + 5 * 1024, 256, 80, 4, l < 3 ? H : nullptr, q->in[I_NMIX] + (l + 1) * 1024, modl + 9 * 6144 + 1024, SS); } PH_END
    }
    PH_BEGIN(18) final_norm_phase(X, q->in[I_FN]); PH_END
#undef PH_BEGIN
#undef PH_END
}

#ifndef MULTI_LAUNCH
#define MULTI_LAUNCH 0
#endif
extern "C" void kernel_launch(void* const* d_in, const int* in_sizes, int n_in, void* d_out, int out_size, void* d_ws, size_t ws_size, hipStream_t stream) {
    static int grid = 0;
    if (grid == 0) {
        int dev = 0, cus = 0, per_cu = 0;
        hipGetDevice(&dev);
        hipDeviceGetAttribute(&cus, hipDeviceAttributeMultiprocessorCount, dev);
        hipFuncSetAttribute((const void*)fwd_kernel, hipFuncAttributeMaxDynamicSharedMemorySize, LDS_BYTES);
        hipOccupancyMaxActiveBlocksPerMultiprocessor(&per_cu, (const void*)fwd_kernel, 512, LDS_BYTES);
        if (per_cu < 1) per_cu = 1;
        grid = cus * 1;
        if (ws_size < WS_END || n_in != 29) { fprintf(stderr, "kernel_launch: ws_size %zu < %zu or n_in %d != 29\n", ws_size, (size_t)WS_END, n_in); }
        (void)hipGetLastError();
    }
    (void)hipMemsetAsync((char*)d_ws + WS_BAR, 0, BAR_BYTES, stream);
    Params p{};
    for (int i = 0; i < 29; ++i) p.in[i] = (const float*)d_in[i];
    p.out = (float*)d_out; p.ws = (unsigned char*)d_ws;
#if MULTI_LAUNCH
    for (int k = 0; k < N_PHASES; ++k) { p.ph_lo = k; p.ph_hi = k + 1; hipLaunchKernelGGL(fwd_kernel, dim3(grid), dim3(512), LDS_BYTES, stream, p); }
#else
    p.ph_lo = 0; p.ph_hi = N_PHASES;
    void* args[] = {&p};
    hipError_t e = hipLaunchCooperativeKernel((const void*)fwd_kernel, dim3(grid), dim3(512), args, LDS_BYTES, stream);
    if (e != hipSuccess) fprintf(stderr, "cooperative launch failed: %s (grid %d)\n", hipGetErrorString(e), grid);
#endif
}
```

```cpp
#include <hip/hip_runtime.h>
#include <hip/hip_cooperative_groups.h>
#include <cstdio>
#include <cstdint>
namespace cg = cooperative_groups;

#define LAS __attribute__((address_space(3)))
typedef unsigned short bf16_t;
typedef short bf16x8 __attribute__((ext_vector_type(8)));
typedef float f32x4 __attribute__((ext_vector_type(4)));
typedef float f32x2 __attribute__((ext_vector_type(2)));
typedef float f32x16 __attribute__((ext_vector_type(16)));
typedef unsigned u32x4 __attribute__((ext_vector_type(4)));
typedef unsigned u32x2 __attribute__((ext_vector_type(2)));

constexpr int D = 1024, MCTX = 4096, M = 20480, FF = 4096, MKV = 22528, KVB = 2304;
constexpr int QW = 1536;
constexpr size_t MiB = 1u << 20;
constexpr size_t WS_MOD = 0, WS_ROPE = 1 * MiB, WS_SP = 1 * MiB + 512 * 1024, WS_BAR = 1 * MiB + 768 * 1024, BAR_BYTES = 16384;
constexpr size_t WS_W1T = 2 * MiB, WS_W2T = 34 * MiB, WS_WINT = 66 * MiB, WS_WGT = 74 * MiB, WS_WOUTT = 76 * MiB, WS_WDQT = 80 * MiB,
                 WS_WUQT = 84 * MiB, WS_WUKT = 87 * MiB, WS_WUVT = 88 * MiB, WS_WOT = 89 * MiB;
constexpr size_t WS_SW = 93 * MiB, WS_SS = 94 * MiB, WS_H = 96 * MiB, WS_S = 136 * MiB, WS_END = 384 * MiB;
constexpr size_t S_A2 = WS_S, S_PART = WS_S + 160 * MiB;
constexpr size_t S_YB = WS_S, S_XC = WS_S + 40 * MiB, S_AB = WS_S + 80 * MiB, S_XB = S_AB, S_CAR = S_XC, S_G = S_YB;
constexpr size_t S_PROJ = WS_S, S_CQ = WS_S + 80 * MiB, S_CKV = WS_S + 100 * MiB, S_KPE = WS_S + 111 * MiB, S_Q = WS_S + 114 * MiB,
                 S_KN = WS_S + 174 * MiB, S_VT = WS_S, S_O = WS_S + 44 * MiB;
static_assert(S_KN + (size_t)MKV * 1024 * 2 <= WS_END && S_AB + 160 * MiB <= WS_END && S_O + 40 * MiB <= S_CKV && S_VT + 44 * MiB <= S_O, "ws map");
constexpr size_t OUT_STATE = (size_t)M * D, OUT_CKV = OUT_STATE + 65536, OUT_KPE = OUT_CKV + 2097152;

constexpr int LDS_BYTES = 147456;

__device__ __forceinline__ unsigned f2bf(float f) { unsigned u = __builtin_bit_cast(unsigned, f); return (u + 0x7fffu + ((u >> 16) & 1u)) >> 16; }
__device__ __forceinline__ unsigned pk2(float lo, float hi) { unsigned r; asm volatile("v_cvt_pk_bf16_f32 %0, %1, %2" : "=v"(r) : "v"(lo), "v"(hi)); return r; }
__device__ __forceinline__ float bflo(unsigned u) { return __builtin_bit_cast(float, u << 16); }
__device__ __forceinline__ float bfhi(unsigned u) { return __builtin_bit_cast(float, u & 0xffff0000u); }
__device__ __forceinline__ float shfl_xor_l(float v, int lane, int o) { return __builtin_bit_cast(float, __builtin_amdgcn_ds_bpermute((lane ^ o) << 2, __builtin_bit_cast(int, v))); }
__device__ __forceinline__ float wave_sum(float v, int lane) {
#pragma unroll
    for (int o = 1; o < 64; o <<= 1) v += shfl_xor_l(v, lane, o);
    return v;
}
struct Params;
typedef const __attribute__((address_space(4))) Params* KArgP;
__device__ __forceinline__ KArgP opaque_kernarg() { auto q = __builtin_amdgcn_kernarg_segment_ptr(); asm volatile("" : "+s"(q)); return (KArgP)q; }
__device__ __forceinline__ int opaque_tid() { int t = threadIdx.x; asm volatile("" : "+v"(t)); return t; }
__device__ __forceinline__ int opaque_bid() { int b = blockIdx.x; asm volatile("" : "+s"(b)); return b; }
__device__ __forceinline__ float sigmoidf_(float x) { return __builtin_amdgcn_rcpf(1.f + __expf(-x)); }
__device__ __forceinline__ int cond_of_tile(int pm) { return pm < 16 ? 0 : 1 + ((pm - 16) >> 3); }

namespace pg8 {
constexpr int BM = 256, BK = 64, HALF = 128, HTB = HALF * BK * 2, STAGE_BYTES = 8 * HTB, NXCD = 8, WGM = 8;
__host__ __device__ __forceinline__ int lds_byte(int r, int c) { const int st = (r >> 4) * 2 + (c >> 5), rr = r & 15, cc = c & 31, ob = rr * 64 + cc * 2; return st * 1024 + (ob ^ (((ob >> 9) & 1) << 5)); }
__host__ __device__ __forceinline__ void stage_rc(int b, int& R, int& C) { const int st = b / 1024, sb = b % 1024, swz = sb ^ (((sb >> 9) & 1) << 5); R = (st >> 1) * 16 + swz / 64; C = (st & 1) * 32 + (swz % 64) / 2; }
__host__ __device__ __forceinline__ int perm32(int rho) { const int n = rho >> 4, i = rho & 15; return 8 * (i >> 2) + 4 * n + (i & 3); }

struct Unit { int pm, pn, kq, idx, which; };
struct Gemm { const bf16_t* A; const bf16_t* Bt; int lda, ldb, K, a_sh, a_colbytes, kq_bytes; const bf16_t* A2; const bf16_t* Bt2; };

__device__ __forceinline__ void unit_of(int wgid, int nM, int nN, Unit& u) {
    const int nwg = nM * nN;
    { const int q = nwg / NXCD, r = nwg % NXCD, xcd = wgid % NXCD, off = wgid / NXCD; wgid = (xcd < r ? xcd * (q + 1) : r * (q + 1) + (xcd - r) * q) + off; }
    const int nig = WGM * nN, gid = wgid / nig, fm = gid * WGM, gsz = (nM - fm) < WGM ? (nM - fm) : WGM;
    u.pm = fm + ((wgid % nig) % gsz); u.pn = (wgid % nig) / gsz; u.kq = 0; u.which = 0;
}
struct StaticOrder {
    int nM, nN, lim, G, c;
    __device__ void init(int M_, int N_, int G_, int c_) { nM = M_ / BM; nN = N_ / BM; lim = nM * nN; G = G_; c = c_; }
    __device__ bool next(int i, Unit& u) const {
        const long L = (long)i * G + c; if (L >= lim) return false;
        unit_of((int)L, nM, nN, u); u.idx = i; return true;
    }
};
struct DualOrder {
    int nM0, nN0, nM1, nN1, G, c;
    __device__ bool next(int i, Unit& u) const {
        const long L = (long)i * G + c; const int n1 = nM0 * nN0;
        if (L >= n1 + nM1 * nN1) return false;
        if (L < n1) unit_of((int)L, nM0, nN0, u); else { unit_of((int)L - n1, nM1, nN1, u); u.which = 1; }
        u.idx = i; return true;
    }
};
struct SplitOrder {
    int nM, nN, base, c;
    __device__ bool next(int i, Unit& u) const {
        if (i > 0) return false; const int L = base + (c >> 2); if (L >= nM * nN) return false;
        unit_of(L, nM, nN, u); u.kq = c & 3; u.idx = 0; return true;
    }
};

__device__ __forceinline__ unsigned cvt_pk_bf16(float lo, float hi) { unsigned r; asm volatile("v_cvt_pk_bf16_f32 %0, %1, %2" : "=v"(r) : "v"(lo), "v"(hi)); return r; }

template <class Epi, class Sched, bool ALIGN_EPI = false, bool SP2 = false>
__device__ __forceinline__ void gemm_phase(LAS unsigned char* lds, const Gemm g, const Sched& S, const Epi& E) {
    const int tid = opaque_tid(), wid = __builtin_amdgcn_readfirstlane(tid >> 6), lane = tid & 63, wr = wid >> 2, wc = wid & 3, fr = lane & 15, fq = lane >> 4;
    int K_ = g.K; asm volatile("" : "+s"(K_)); const int K = K_, nt = K / BK;
    unsigned voffA[2], voffB[2];
#pragma unroll
    for (int i = 0; i < 2; ++i) { int R, C; stage_rc(tid * 16 + i * 8192, R, C); const int Rb = Epi::PERM ? ((R & ~31) + perm32(R & 31)) : R;
        voffA[i] = (unsigned)(R * g.lda + C) * 2u; voffB[i] = (unsigned)(Rb * g.ldb + C) * 2u; }
    const size_t kstep = (size_t)(BK * 2);
    const size_t hA = (size_t)HALF * g.lda * 2, hB = (size_t)HALF * g.ldb * 2;
    const size_t tA = 2 * hA, tB = 2 * hB;
    const unsigned ldsw = (unsigned)wid * 1024u;
    const int aoff = lds_byte(wr * 64 + fr, fq * 8), boff = lds_byte(wc * 32 + fr, fq * 8);
#define PG8_SA(b, h) (((b) * 2 + (h)) * HTB)
#define PG8_SB(b, h) ((4 + (b) * 2 + (h)) * HTB)
#define PG8_STAGE(bufoff, gbase, voff) do { const char* _gb = (const char*)(gbase); asm volatile("" : "+s"(_gb)); _Pragma("unroll") for (int _i = 0; _i < 2; ++_i) \
        __builtin_amdgcn_global_load_lds((const unsigned*)(_gb + (voff)[_i]), (LAS unsigned*)(lds + (bufoff) + ldsw + _i * 8192), 16, 0, 0); } while (0)
#define PG8_LDA(dst, b, h) do { _Pragma("unroll") for (int m = 0; m < 4; ++m) _Pragma("unroll") for (int k = 0; k < 2; ++k) dst[m][k] = *(const LAS bf16x8*)(lds + PG8_SA(b, h) + aoff + m * 2048 + k * 1024); } while (0)
#define PG8_LDB(dst, b, h) do { _Pragma("unroll") for (int n = 0; n < 2; ++n) _Pragma("unroll") for (int k = 0; k < 2; ++k) dst[n][k] = *(const LAS bf16x8*)(lds + PG8_SB(b, h) + boff + n * 2048 + k * 1024); } while (0)
#define PG8_MMA(ai, bj, At, Bt) do { __builtin_amdgcn_s_setprio(1); _Pragma("unroll") for (int m = 0; m < 4; ++m) _Pragma("unroll") for (int n = 0; n < 2; ++n) _Pragma("unroll") for (int k = 0; k < 2; ++k) \
        acc[ai][bj][m][n] = __builtin_amdgcn_mfma_f32_16x16x32_bf16(Bt[n][k], At[m][k], acc[ai][bj][m][n], 0, 0, 0); __builtin_amdgcn_s_setprio(0); } while (0)
#define PG8_WAIT_V(n) asm volatile("s_waitcnt vmcnt(" #n ")" ::: "memory")
#define PG8_WAIT_L(n) asm volatile("s_waitcnt lgkmcnt(" #n ")" ::: "memory")
#define PG8_BAR __builtin_amdgcn_s_barrier()
#define PG8_SCHED __builtin_amdgcn_sched_barrier(0)
#define PG8_OFFA(u) ((size_t)(u).pm * tA + (size_t)((u).pn >> g.a_sh) * (size_t)g.a_colbytes + (size_t)(u).kq * (size_t)g.kq_bytes)
#define PG8_OFFB(u) ((size_t)(u).pn * tB + (size_t)(u).kq * (size_t)g.kq_bytes)
    Unit cur, nxt; int ui = 0;
    if (!S.next(0, cur)) return;
    f32x4 acc[2][2][4][2];
#pragma unroll
    for (int a = 0; a < 2; ++a)
#pragma unroll
        for (int b = 0; b < 2; ++b)
#pragma unroll
            for (int m = 0; m < 4; ++m)
#pragma unroll
                for (int n = 0; n < 2; ++n) acc[a][b][m][n] = (f32x4){0.f, 0.f, 0.f, 0.f};
    bf16x8 At[4][2], B0[2][2], B1[2][2];
    const char* cA = (const char*)(cur.which ? g.A2 : g.A) + PG8_OFFA(cur); const char* cB = (const char*)(cur.which ? g.Bt2 : g.Bt) + PG8_OFFB(cur);
    if constexpr (SP2) {
        PG8_STAGE(PG8_SB(0, 0), cB, voffB); PG8_STAGE(PG8_SB(0, 1), cB + hB, voffB); PG8_STAGE(PG8_SA(0, 0), cA, voffA); PG8_STAGE(PG8_SA(0, 1), cA + hA, voffA);
        if (wr == 1) PG8_BAR;
        PG8_WAIT_V(2); PG8_BAR;
        PG8_STAGE(PG8_SB(1, 0), cB + kstep, voffB); PG8_STAGE(PG8_SA(1, 0), cA + kstep, voffA); PG8_STAGE(PG8_SB(1, 1), cB + hB + kstep, voffB);
        PG8_WAIT_V(6); PG8_BAR;
    } else {
        PG8_STAGE(PG8_SB(0, 0), cB, voffB); PG8_STAGE(PG8_SA(0, 0), cA, voffA); PG8_STAGE(PG8_SB(0, 1), cB + hB, voffB); PG8_STAGE(PG8_SA(0, 1), cA + hA, voffA);
        if (wr == 1) PG8_BAR;
        PG8_WAIT_V(4); PG8_BAR;
        PG8_STAGE(PG8_SB(1, 0), cB + kstep, voffB); PG8_STAGE(PG8_SA(1, 0), cA + kstep, voffA); PG8_STAGE(PG8_SB(1, 1), cB + hB + kstep, voffB);
        PG8_WAIT_V(6); PG8_BAR;
    }
    for (;;) {
        const bool has_next = S.next(ui + 1, nxt);
        const char* nA = has_next ? (const char*)(nxt.which ? g.A2 : g.A) + PG8_OFFA(nxt) : cA; const char* nB = has_next ? (const char*)(nxt.which ? g.Bt2 : g.Bt) + PG8_OFFB(nxt) : cB;
        for (int t = 0; t < nt; t += 2) {
            const bool last = (t == nt - 2);
            const char* a1 = cA + (size_t)(t + 1) * kstep;
            const char* a2 = last ? nA : cA + (size_t)(t + 2) * kstep; const char* b2 = last ? nB : cB + (size_t)(t + 2) * kstep;
            const char* a3 = a2 + kstep; const char* b3 = b2 + kstep;
            if constexpr (SP2) {
            PG8_LDB(B0, 0, 0); PG8_LDB(B1, 0, 1); PG8_SCHED; PG8_LDA(At, 0, 0); PG8_STAGE(PG8_SA(1, 1), a1 + hA, voffA);
            PG8_WAIT_V(8); PG8_WAIT_L(0); PG8_BAR; PG8_MMA(0, 0, At, B0); PG8_MMA(0, 1, At, B1); PG8_BAR; PG8_SCHED;
            PG8_LDA(At, 0, 1); PG8_STAGE(PG8_SB(0, 0), b2, voffB); PG8_STAGE(PG8_SB(0, 1), b2 + hB, voffB); PG8_STAGE(PG8_SA(0, 0), a2, voffA);
            PG8_WAIT_V(8); PG8_WAIT_L(0); PG8_BAR; PG8_MMA(1, 0, At, B0); PG8_MMA(1, 1, At, B1); PG8_BAR; PG8_SCHED;
            PG8_LDB(B0, 1, 0); PG8_LDB(B1, 1, 1); PG8_SCHED; PG8_LDA(At, 1, 0); PG8_STAGE(PG8_SA(0, 1), a2 + hA, voffA);
            PG8_WAIT_V(8); PG8_WAIT_L(0); PG8_BAR; PG8_MMA(0, 0, At, B0); PG8_MMA(0, 1, At, B1); PG8_BAR; PG8_SCHED;
            PG8_LDA(At, 1, 1); PG8_STAGE(PG8_SB(1, 0), b3, voffB); PG8_STAGE(PG8_SB(1, 1), b3 + hB, voffB); PG8_STAGE(PG8_SA(1, 0), a3, voffA);
            PG8_WAIT_V(8); PG8_WAIT_L(0); PG8_BAR; PG8_MMA(1, 0, At, B0); PG8_MMA(1, 1, At, B1); PG8_BAR; PG8_SCHED;
            } else {
            PG8_LDB(B0, 0, 0); PG8_SCHED; PG8_LDA(At, 0, 0); PG8_STAGE(PG8_SA(1, 1), a1 + hA, voffA);
            PG8_WAIT_L(8); PG8_BAR; PG8_WAIT_L(0); PG8_MMA(0, 0, At, B0); PG8_BAR; PG8_SCHED;
            PG8_LDB(B1, 0, 1); PG8_STAGE(PG8_SB(0, 0), b2, voffB);
            PG8_BAR; PG8_WAIT_L(0); PG8_MMA(0, 1, At, B1); PG8_BAR;
            PG8_LDA(At, 0, 1); PG8_STAGE(PG8_SA(0, 0), a2, voffA);
            PG8_BAR; PG8_WAIT_L(0); PG8_MMA(1, 0, At, B0); PG8_BAR; PG8_SCHED;
            PG8_STAGE(PG8_SB(0, 1), b2 + hB, voffB);
            PG8_WAIT_V(6); PG8_BAR; PG8_MMA(1, 1, At, B1); PG8_BAR;
            PG8_LDB(B0, 1, 0); PG8_SCHED; PG8_LDA(At, 1, 0); PG8_STAGE(PG8_SA(0, 1), a2 + hA, voffA);
            PG8_WAIT_L(8); PG8_BAR; PG8_WAIT_L(0); PG8_MMA(0, 0, At, B0); PG8_BAR; PG8_SCHED;
            PG8_LDB(B1, 1, 1); PG8_STAGE(PG8_SB(1, 0), b3, voffB);
            PG8_BAR; PG8_WAIT_L(0); PG8_MMA(0, 1, At, B1); PG8_BAR;
            PG8_LDA(At, 1, 1); PG8_STAGE(PG8_SA(1, 0), a3, voffA);
            PG8_BAR; PG8_WAIT_L(0); PG8_MMA(1, 0, At, B0); PG8_BAR; PG8_SCHED;
            PG8_STAGE(PG8_SB(1, 1), b3 + hB, voffB);
            PG8_WAIT_V(6); PG8_BAR; PG8_MMA(1, 1, At, B1); PG8_BAR;
            }
        }
        if constexpr (ALIGN_EPI) { if (wr == 0) PG8_BAR; }
        { int t2 = threadIdx.x; asm volatile("" : "+v"(t2)); const int w2 = t2 >> 6, l2 = t2 & 63; E(acc, cur, w2 >> 2, w2 & 3, l2 & 15, l2 >> 4); }
        if (!has_next) break;
#pragma unroll
        for (int a = 0; a < 2; ++a)
#pragma unroll
            for (int b = 0; b < 2; ++b)
#pragma unroll
                for (int m = 0; m < 4; ++m)
#pragma unroll
                    for (int n = 0; n < 2; ++n) acc[a][b][m][n] = (f32x4){0.f, 0.f, 0.f, 0.f};
        cur = nxt; cA = nA; cB = nB; ++ui;
        if constexpr (ALIGN_EPI) { if (wr == 1) PG8_BAR; }
    }
    PG8_WAIT_V(0);
    if constexpr (!ALIGN_EPI) { if (wr == 0) PG8_BAR; }
    PG8_BAR;
#undef PG8_SA
#undef PG8_SB
#undef PG8_STAGE
#undef PG8_LDA
#undef PG8_LDB
#undef PG8_MMA
#undef PG8_WAIT_V
#undef PG8_WAIT_L
#undef PG8_BAR
#undef PG8_SCHED
#undef PG8_OFFA
#undef PG8_OFFB
}
}

typedef f32x4 AccT[2][2][4][2];

template <int MODE, bool NORM = false> struct EpiBf16 {
    static constexpr bool PERM = true;
    bf16_t* O; bf16_t* O2; int ldc; const float* ss; const float* sw;
    __device__ __forceinline__ void operator()(const AccT& acc, const pg8::Unit& u, int wr, int wc, int fr, int fq) const {
        const int row0 = u.pm * 256 + wr * 64 + fr; int colt = u.pn * 256; bf16_t* base = O; bool act = (MODE == 1);
        if (MODE == 2) { if (colt >= 1024) { colt -= 1024; base = O2; act = true; } }
        const int col0 = colt + wc * 32 + 8 * fq;
        f32x4 sv[2][2];
        if (NORM) { const float* swp = sw + (size_t)cond_of_tile(u.pm) * 6144 + u.pn * 256 + wc * 32 + 8 * fq;
#pragma unroll
            for (int bj = 0; bj < 2; ++bj) { sv[bj][0] = *(const f32x4*)(swp + bj * 128); sv[bj][1] = *(const f32x4*)(swp + bj * 128 + 4); } }
        float rsd[2][4];
        if (NORM) { f32x4 t[2][4]; const int lane = fq * 16 + fr;
#pragma unroll
            for (int ai = 0; ai < 2; ++ai)
#pragma unroll
                for (int m = 0; m < 4; ++m) t[ai][m] = *(const f32x4*)(ss + (size_t)(row0 + ai * 128 + m * 16) * 16 + 4 * fq);
#pragma unroll
            for (int ai = 0; ai < 2; ++ai)
#pragma unroll
                for (int m = 0; m < 4; ++m) { float q = (t[ai][m][0] + t[ai][m][1]) + (t[ai][m][2] + t[ai][m][3]); q += shfl_xor_l(q, lane, 16); q += shfl_xor_l(q, lane, 32);
                    rsd[ai][m] = rsqrtf(q * (1.f / 1024.f) + 1e-6f); } }
#pragma unroll
        for (int ai = 0; ai < 2; ++ai)
#pragma unroll
            for (int m = 0; m < 4; ++m) { const int row = row0 + ai * 128 + m * 16; bf16_t* rowp = base + (size_t)row * ldc + col0;
                float rstd = 1.f;
                if (NORM) rstd = rsd[ai][m];
#pragma unroll
                for (int bj = 0; bj < 2; ++bj) { f32x4 v0 = acc[ai][bj][m][0], v1 = acc[ai][bj][m][1];
                    if (NORM) { v0 = v0 * rstd + sv[bj][0]; v1 = v1 * rstd + sv[bj][1]; }
                    if (act) {
#pragma unroll
                        for (int j = 0; j < 4; ++j) {
                            if (MODE == 1) { float a = fmaxf(v0[j], 0.f), b = fmaxf(v1[j], 0.f); v0[j] = a * a; v1[j] = b * b; }
                            else { float x = v0[j], y = v1[j];
                                   float ux = 1.5957691216f * (x + 0.044715f * x * x * x), uy = 1.5957691216f * (y + 0.044715f * y * y * y);
                                   v0[j] = x * __builtin_amdgcn_rcpf(1.f + __expf(-ux)); v1[j] = y * __builtin_amdgcn_rcpf(1.f + __expf(-uy)); }
                        }
                    }
                    u32x4 w; w.x = pg8::cvt_pk_bf16(v0[0], v0[1]); w.y = pg8::cvt_pk_bf16(v0[2], v0[3]); w.z = pg8::cvt_pk_bf16(v1[0], v1[1]); w.w = pg8::cvt_pk_bf16(v1[2], v1[3]);
                    *(u32x4*)(rowp + bj * 128) = w; } }
    }
};
struct EpiF32 {
    static constexpr bool PERM = false;
    float* O; int ldc; const float* ss; const float* sw;
    __device__ __forceinline__ void operator()(const AccT& acc, const pg8::Unit& u, int wr, int wc, int fr, int fq) const {
        const int row0 = u.pm * 256 + wr * 64 + fr, col0 = u.pn * 256 + wc * 32 + 4 * fq;
        const float* swp = sw + (size_t)cond_of_tile(u.pm) * 6144 + col0;
        f32x4 sv[2][2];
#pragma unroll
        for (int bj = 0; bj < 2; ++bj)
#pragma unroll
            for (int n = 0; n < 2; ++n) sv[bj][n] = *(const f32x4*)(swp + bj * 128 + n * 16);
        float rsd[2][4];
        { f32x4 t[2][4]; const int lane = fq * 16 + fr;
#pragma unroll
            for (int ai = 0; ai < 2; ++ai)
#pragma unroll
                for (int m = 0; m < 4; ++m) t[ai][m] = *(const f32x4*)(ss + (size_t)(row0 + ai * 128 + m * 16) * 16 + 4 * fq);
#pragma unroll
            for (int ai = 0; ai < 2; ++ai)
#pragma unroll
                for (int m = 0; m < 4; ++m) { float q = (t[ai][m][0] + t[ai][m][1]) + (t[ai][m][2] + t[ai][m][3]); q += shfl_xor_l(q, lane, 16); q += shfl_xor_l(q, lane, 32);
                    rsd[ai][m] = rsqrtf(q * (1.f / 1024.f) + 1e-6f); } }
#pragma unroll
        for (int ai = 0; ai < 2; ++ai)
#pragma unroll
            for (int m = 0; m < 4; ++m) { const int row = row0 + ai * 128 + m * 16; float* rowp = O + (size_t)row * ldc + col0;
                const float rstd = rsd[ai][m];
#pragma unroll
                for (int bj = 0; bj < 2; ++bj)
#pragma unroll
                    for (int n = 0; n < 2; ++n) *(f32x4*)(rowp + bj * 128 + n * 16) = acc[ai][bj][m][n] * rstd + sv[bj][n]; }
    }
};
struct EpiResid {
    static constexpr bool PERM = true;
    const float* base0; const float* base1; float* out; const float* gate;
    bf16_t* XG; const float* gn; const float* sc; float* ss;
    __device__ __forceinline__ void operator()(const AccT& acc, const pg8::Unit& u, int wr, int wc, int fr, int fq) const {
        const int row0 = u.pm * 256 + wr * 64 + fr, col0 = u.pn * 256 + wc * 32 + 8 * fq, cnd = cond_of_tile(u.pm), lane = fq * 16 + fr;
        const float* gp = gate + (size_t)cnd * 6144 + col0;
        const float* bp = (u.pm < 16) ? base0 : base1 - (size_t)MCTX * D;
        const bool xg = XG != nullptr;
        f32x4 gv[2][2], gm[2][2]; float sqa[2][4];
#pragma unroll
        for (int bj = 0; bj < 2; ++bj)
#pragma unroll
            for (int n = 0; n < 2; ++n) { gv[bj][n] = *(const f32x4*)(gp + bj * 128 + n * 4);
                if (xg) gm[bj][n] = *(const f32x4*)(gn + col0 + bj * 128 + n * 4) * (*(const f32x4*)(sc + (size_t)cnd * 6144 + col0 + bj * 128 + n * 4) + 1.f);
                else gm[bj][n] = (f32x4){0.f, 0.f, 0.f, 0.f}; }
#pragma unroll
        for (int aim = 0; aim < 4; ++aim) { const int ai = aim >> 1, mb = (aim & 1) * 2;
            f32x4 bb[4][2][2];
#pragma unroll
            for (int m = mb; m < mb + 2; ++m)
#pragma unroll
                for (int bj = 0; bj < 2; ++bj)
#pragma unroll
                    for (int n = 0; n < 2; ++n) bb[m][bj][n] = *(const f32x4*)(bp + (size_t)(row0 + ai * 128 + m * 16) * D + col0 + bj * 128 + n * 4);
#pragma unroll
            for (int m = mb; m < mb + 2; ++m) { const int row = row0 + ai * 128 + m * 16; const size_t off = (size_t)row * D + col0; float sq = 0.f;
#pragma unroll
                for (int bj = 0; bj < 2; ++bj) {
                    const f32x4 x0 = bb[m][bj][0] + gv[bj][0] * acc[ai][bj][m][0], x1 = bb[m][bj][1] + gv[bj][1] * acc[ai][bj][m][1];
                    *(f32x4*)(out + off + bj * 128) = x0; *(f32x4*)(out + off + bj * 128 + 4) = x1;
                    if (xg) { sq += ((x0[0] * x0[0] + x0[1] * x0[1]) + (x0[2] * x0[2] + x0[3] * x0[3])) + ((x1[0] * x1[0] + x1[1] * x1[1]) + (x1[2] * x1[2] + x1[3] * x1[3]));
                        const f32x4 y0 = x0 * gm[bj][0], y1 = x1 * gm[bj][1];
                        *(u32x4*)(XG + off + bj * 128) = (u32x4){pg8::cvt_pk_bf16(y0[0], y0[1]), pg8::cvt_pk_bf16(y0[2], y0[3]), pg8::cvt_pk_bf16(y1[0], y1[1]), pg8::cvt_pk_bf16(y1[2], y1[3])}; } }
                sqa[ai][m] = sq; }
        }
        if (xg) {
#pragma unroll
            for (int ai = 0; ai < 2; ++ai)
#pragma unroll
                for (int m = 0; m < 4; ++m) sqa[ai][m] += shfl_xor_l(sqa[ai][m], lane, 16);
#pragma unroll
            for (int ai = 0; ai < 2; ++ai)
#pragma unroll
                for (int m = 0; m < 4; ++m) sqa[ai][m] += shfl_xor_l(sqa[ai][m], lane, 32);
            if (fq == 0) {
#pragma unroll
                for (int ai = 0; ai < 2; ++ai)
#pragma unroll
                    for (int m = 0; m < 4; ++m) ss[(size_t)(row0 + ai * 128 + m * 16) * 16 + u.pn * 4 + wc] = sqa[ai][m]; }
        }
    }
};
struct EpiGates {
    static constexpr bool PERM = true;
    const bf16_t* XC; unsigned* AB; const float* ba; const float* bx; const float* sp;
    __device__ __forceinline__ void operator()(const AccT& acc, const pg8::Unit& u, int wr, int wc, int fr, int fq) const {
        const int blk = u.pn >> 1, dir = u.pn & 1;
        const int row0 = u.pm * 256 + wr * 64 + fr, ch0 = blk * 128 + wc * 32 + 8 * fq;
        unsigned* ab = AB + (size_t)dir * M * 1024;
        u32x2 xwa[2][2][4];
#pragma unroll
        for (int n = 0; n < 2; ++n)
#pragma unroll
            for (int ai = 0; ai < 2; ++ai)
#pragma unroll
                for (int m = 0; m < 4; ++m) xwa[n][ai][m] = *(const u32x2*)(XC + (size_t)(row0 + ai * 128 + m * 16) * 1024 + ch0 + 4 * n);
#pragma unroll
        for (int n = 0; n < 2; ++n) {
            const f32x4 vba = *(const f32x4*)(ba + dir * 1024 + ch0 + 4 * n), vbx = *(const f32x4*)(bx + dir * 1024 + ch0 + 4 * n), vsp = *(const f32x4*)(sp + dir * 1024 + ch0 + 4 * n);
#pragma unroll
            for (int ai = 0; ai < 2; ++ai)
#pragma unroll
                for (int m = 0; m < 4; ++m) { const size_t off = (size_t)(row0 + ai * 128 + m * 16) * 1024 + ch0 + 4 * n;
                    const u32x2 xw = xwa[n][ai][m];
                    const float xf[4] = {bflo(xw.x), bfhi(xw.x), bflo(xw.y), bfhi(xw.y)};
                    unsigned o[4];
#pragma unroll
                    for (int j = 0; j < 4; ++j) {
                        const float r = sigmoidf_(acc[ai][0][m][n][j] + vba[j]);
                        const float la = -r * vsp[j];
                        const float uu = fmaxf(1.f - __expf(2.f * la), 1e-20f), vv = 1.f + __expf(-(acc[ai][1][m][n][j] + vbx[j]));
                        const float bb = uu * __builtin_amdgcn_rsqf(uu * vv * vv) * xf[j];
                        o[j] = pk2(la, bb); }
                    *(u32x4*)(ab + off) = (u32x4){o[0], o[1], o[2], o[3]};
                    __builtin_amdgcn_sched_barrier(0); }
        }
    }
};
struct EpiQ {
    static constexpr bool PERM = true;
    bf16_t* Q; const float* rope; float qscale;
    __device__ __forceinline__ void operator()(const AccT& acc, const pg8::Unit& u, int wr, int wc, int fr, int fq) const {
        const int row0 = u.pm * 256 + wr * 64 + fr;
#pragma unroll
        for (int bj = 0; bj < 2; ++bj) {
            const int col0 = u.pn * 256 + bj * 128 + wc * 32 + 8 * fq; const int within = col0 % 192;
            const bool pe = (within >= 128) && (u.pm >= 16); const int i0 = pe ? ((within - 128) >> 1) : 0;
            bf16_t* qp = Q + (size_t)row0 * QW + col0;
            const float* rp0 = rope + (size_t)i0 * 2;
#pragma unroll
            for (int ai = 0; ai < 2; ++ai)
#pragma unroll
                for (int m = 0; m < 4; ++m) { const int rr = ai * 128 + m * 16;
                    f32x4 v0 = acc[ai][bj][m][0], v1 = acc[ai][bj][m][1];
                    if (pe) { const int pos = (row0 + rr - MCTX) & 2047; const float* rp = rp0 + (size_t)pos * 64;
                        const f32x4 r0 = *(const f32x4*)rp, r1 = *(const f32x4*)(rp + 4);
                        const f32x4 a = v0, b = v1;
                        v0[0] = a[0] * r0[0] - a[1] * r0[1]; v0[1] = a[0] * r0[1] + a[1] * r0[0];
                        v0[2] = a[2] * r0[2] - a[3] * r0[3]; v0[3] = a[2] * r0[3] + a[3] * r0[2];
                        v1[0] = b[0] * r1[0] - b[1] * r1[1]; v1[1] = b[0] * r1[1] + b[1] * r1[0];
                        v1[2] = b[2] * r1[2] - b[3] * r1[3]; v1[3] = b[2] * r1[3] + b[3] * r1[2]; }
                    v0 = v0 * qscale; v1 = v1 * qscale;
                    u32x4 w; w.x = pg8::cvt_pk_bf16(v0[0], v0[1]); w.y = pg8::cvt_pk_bf16(v0[2], v0[3]); w.z = pg8::cvt_pk_bf16(v1[0], v1[1]); w.w = pg8::cvt_pk_bf16(v1[2], v1[3]);
                    *(u32x4*)(qp + (size_t)rr * QW) = w;
                    __builtin_amdgcn_sched_barrier(0); }
        }
    }
};

__device__ __forceinline__ void rstd_prepass(LAS float* rs, const float* ss, int Mr, int N) {
    pg8::StaticOrder S; S.init(Mr, N, (int)gridDim.x, opaque_bid());
    const int tid = opaque_tid(), lane = tid & 63, rl = tid >> 1, half = tid & 1;
    pg8::Unit u;
    for (int i = 0; S.next(i, u); ++i) {
        const float* sp = ss + (size_t)(u.pm * 256 + rl) * 16 + half * 8;
        const f32x4 a = *(const f32x4*)sp, b = *(const f32x4*)(sp + 4); const f32x4 t4 = a + b;
        float t = (t4[0] + t4[1]) + (t4[2] + t4[3]); t += shfl_xor_l(t, lane, 1);
        if (half == 0) rs[i * 256 + rl] = rsqrtf(t * (1.f / 1024.f) + 1e-6f);
    }
    __syncthreads();
}
template <class Epi>
__device__ __forceinline__ void run_gemm(LAS unsigned char* lds, const bf16_t* A, int lda, const bf16_t* Bt, int ldb, int Mr, int N, int K, int a_sh, int a_colbytes, const Epi& E, int lim = 1 << 30) {
    pg8::Gemm g{A, Bt, lda, ldb, K, a_sh, a_colbytes, 0, nullptr, nullptr};
    pg8::StaticOrder S; S.init(Mr, N, (int)gridDim.x, opaque_bid()); if (lim < S.lim) S.lim = lim;
    pg8::gemm_phase<Epi, pg8::StaticOrder, true, true>(lds, g, S, E);
}
struct EpiDual {
    static constexpr bool PERM = true;
    bf16_t* O0; int ld0; bf16_t* O1; int ld1;
    __device__ __forceinline__ void operator()(const AccT& acc, const pg8::Unit& u, int wr, int wc, int fr, int fq) const {
        bf16_t* base = u.which ? O1 : O0; const int ldc = u.which ? ld1 : ld0;
        const int row0 = u.pm * 256 + wr * 64 + fr, col0 = u.pn * 256 + wc * 32 + 8 * fq;
#pragma unroll
        for (int ai = 0; ai < 2; ++ai)
#pragma unroll
            for (int m = 0; m < 4; ++m) { bf16_t* rowp = base + (size_t)(row0 + ai * 128 + m * 16) * ldc + col0;
#pragma unroll
                for (int bj = 0; bj < 2; ++bj) { const f32x4 v0 = acc[ai][bj][m][0], v1 = acc[ai][bj][m][1];
                    u32x4 w; w.x = pg8::cvt_pk_bf16(v0[0], v0[1]); w.y = pg8::cvt_pk_bf16(v0[2], v0[3]); w.z = pg8::cvt_pk_bf16(v1[0], v1[1]); w.w = pg8::cvt_pk_bf16(v1[2], v1[3]);
                    *(u32x4*)(rowp + bj * 128) = w; } }
    }
};
__device__ __forceinline__ void run_gemm_dual(LAS unsigned char* lds, const bf16_t* A0, const bf16_t* B0, int M0, int N0, const bf16_t* A1, const bf16_t* B1, int M1, int N1, int ld, int K, const EpiDual& E) {
    pg8::Gemm g{A0, B0, ld, ld, K, 0, 0, 0, A1, B1};
    pg8::DualOrder S{M0 / 256, N0 / 256, M1 / 256, N1 / 256, (int)gridDim.x, opaque_bid()};
    pg8::gemm_phase<EpiDual, pg8::DualOrder, true, true>(lds, g, S, E);
}
struct EpiPartial {
    static constexpr bool PERM = false;
    float* part; int base, nM, nN;
    __device__ __forceinline__ void operator()(const AccT& acc, const pg8::Unit& u, int wr, int wc, int fr, int fq) const {
        const int slot = opaque_bid();
        float* O = part + (size_t)slot * 65536;
        const int row0 = wr * 64 + fr, col0 = wc * 32 + 4 * fq;
#pragma unroll
        for (int ai = 0; ai < 2; ++ai)
#pragma unroll
            for (int m = 0; m < 4; ++m) { float* rowp = O + (size_t)(row0 + ai * 128 + m * 16) * 256 + col0;
#pragma unroll
                for (int bj = 0; bj < 2; ++bj)
#pragma unroll
                    for (int n = 0; n < 2; ++n) *(f32x4*)(rowp + bj * 128 + n * 16) = acc[ai][bj][m][n]; }
    }
};
template <class Epi>
__device__ __forceinline__ void run_gemm_split(LAS unsigned char* lds, const bf16_t* A, int lda, const bf16_t* Bt, int ldb, int Mr, int N, int Kq, int base, const Epi& E) {
    pg8::Gemm g{A, Bt, lda, ldb, Kq, 0, 0, Kq * 2, nullptr, nullptr};
    pg8::SplitOrder S{Mr / 256, N / 256, base, opaque_bid()};
    pg8::gemm_phase<Epi, pg8::SplitOrder, true, true>(lds, g, S, E);
}
__device__ __forceinline__ void split_reduce_phase(const float* part, float* X, const float* gate, int base, int nM, int nN, bf16_t* XG, const float* gn, const float* sc, float* ss) {
    const int tid_ = opaque_tid(), lane = tid_ & 63; const int gt = opaque_bid() * 512 + tid_, NT = gridDim.x * 512;
    const int nsplit = nM * nN - base, nit = nsplit * 16384;
    for (int it0 = gt; it0 < nit; it0 += 4 * NT) {
        f32x4 p[4][4], xo[4], gv[4], gm[4]; int rowv[4], colv[4], pnv[4]; bool ok[4];
#pragma unroll
        for (int i = 0; i < 4; ++i) { const int it = it0 + i * NT; ok[i] = it < nit;
            const int itc = ok[i] ? it : it0;
            const int su = itc >> 14, e = itc & 16383, r = e >> 6, c4 = (e & 63) * 4;
            pg8::Unit u; pg8::unit_of(base + su, nM, nN, u);
            const float* pp = part + (size_t)su * 4 * 65536 + r * 256 + c4;
#pragma unroll
            for (int k4 = 0; k4 < 4; ++k4) p[i][k4] = *(const f32x4*)(pp + (size_t)k4 * 65536);
            rowv[i] = u.pm * 256 + r; colv[i] = u.pn * 256 + c4; pnv[i] = u.pn; const int cnd = cond_of_tile(u.pm);
            xo[i] = *(const f32x4*)(X + (size_t)rowv[i] * D + colv[i]);
            gv[i] = *(const f32x4*)(gate + (size_t)cnd * 6144 + colv[i]);
            if (XG != nullptr) gm[i] = *(const f32x4*)(gn + colv[i]) * (*(const f32x4*)(sc + (size_t)cnd * 6144 + colv[i]) + 1.f); else gm[i] = (f32x4){0.f, 0.f, 0.f, 0.f}; }
        float sq[4];
#pragma unroll
        for (int i = 0; i < 4; ++i) { const f32x4 s4 = (p[i][0] + p[i][1]) + (p[i][2] + p[i][3]); const f32x4 xn = xo[i] + gv[i] * s4;
            if (ok[i]) *(f32x4*)(X + (size_t)rowv[i] * D + colv[i]) = xn;
            sq[i] = (xn[0] * xn[0] + xn[1] * xn[1]) + (xn[2] * xn[2] + xn[3] * xn[3]);
            if (XG != nullptr && ok[i]) { const f32x4 y = xn * gm[i]; *(u32x2*)(XG + (size_t)rowv[i] * D + colv[i]) = (u32x2){pk2(y[0], y[1]), pk2(y[2], y[3])}; } }
        if (XG != nullptr) {
#pragma unroll
            for (int o_ = 1; o_ < 64; o_ <<= 1) {
#pragma unroll
                for (int i = 0; i < 4; ++i) sq[i] += shfl_xor_l(sq[i], lane, o_); }
#pragma unroll
            for (int i = 0; i < 4; ++i) if (ok[i] && lane < 4) ss[(size_t)rowv[i] * 16 + pnv[i] * 4 + lane] = lane == 0 ? sq[i] : 0.f;
        }
    }
}
__device__ __forceinline__ void sw_phase(const float* mod, const unsigned char* ws, float* sW) {
    const int tid_ = opaque_tid(), lane = tid_ & 63, gw = opaque_bid() * 8 + (tid_ >> 6), NGW = gridDim.x * 8;
    const int r16 = lane & 15, q = lane >> 4;
    for (int it = gw; it < 1408; it += NGW) {
        int l = 0, n0 = 0; bool up = false;
        { int r = it;
          for (int ll = 0; ll < 4; ++ll) { const int nmix = (ll & 1) ? 64 : 128;
              if (r < nmix) { l = ll; n0 = r * 16; up = false; break; } r -= nmix;
              if (r < 256) { l = ll; n0 = r * 16; up = true; break; } r -= 256; } }
        const int j = l >> 1;
        const bf16_t* wt;
        if (up) wt = (const bf16_t*)(ws + WS_W1T) + ((size_t)l * 4096 + n0) * 1024;
        else if (l & 1) wt = (const bf16_t*)(ws + WS_WDQT) + ((size_t)j * 1024 + n0) * 1024;
        else wt = (const bf16_t*)(ws + WS_WINT) + ((size_t)j * 2048 + n0) * 1024;
        const bf16_t* wp = wt + (size_t)r16 * 1024 + 8 * q;
        const bool cv = r16 < 9;
        const float* shp = mod + ((size_t)l * 9 + (cv ? r16 : 0)) * 6144 + (up ? 3 : 0) * 1024 + 8 * q;
        f32x4 acc = (f32x4){0.f, 0.f, 0.f, 0.f};
#pragma unroll 1
        for (int kb = 0; kb < 4; ++kb) {
            bf16x8 bfr[8]; f32x4 a0[8], a1[8];
#pragma unroll
            for (int s8 = 0; s8 < 8; ++s8) { const int k0 = kb * 256 + s8 * 32;
                bfr[s8] = *(const bf16x8*)(wp + k0); a0[s8] = *(const f32x4*)(shp + k0); a1[s8] = *(const f32x4*)(shp + k0 + 4); }
#pragma unroll
            for (int s8 = 0; s8 < 8; ++s8) { u32x4 aw;
                aw.x = pk2(a0[s8][0], a0[s8][1]); aw.y = pk2(a0[s8][2], a0[s8][3]); aw.z = pk2(a1[s8][0], a1[s8][1]); aw.w = pk2(a1[s8][2], a1[s8][3]);
                if (!cv) aw = (u32x4){0u, 0u, 0u, 0u};
                acc = __builtin_amdgcn_mfma_f32_16x16x32_bf16(__builtin_bit_cast(bf16x8, aw), bfr[s8], acc, 0, 0, 0); }
        }
#pragma unroll
        for (int i = 0; i < 4; ++i) { const int cnd = 4 * q + i; if (cnd < 9) sW[((size_t)l * 9 + cnd) * 6144 + (up ? 2048 : 0) + n0 + r16] = acc[i]; }
    }
}

struct Params { const float* in[29]; float* out; unsigned char* ws; int ph_lo, ph_hi; };
enum { I_XP = 0, I_XS, I_STATE, I_CCKV, I_CKPE, I_C, I_CCTX, I_ADAW, I_ADAB, I_NMIX, I_NMLP, I_W1, I_W2, I_WIN, I_CONVW, I_CONVB, I_WA, I_BA, I_WX, I_BX, I_LAM, I_WOUT,
       I_WDQ, I_NQ, I_NKV, I_WUQ, I_WUKV, I_WO, I_FN };

__device__ __forceinline__ void transpose_item(const float* src, int ldsrc, int k0, int n0, bf16_t* dstrow0, int lddst, LAS float* scr, int lane) {
#pragma unroll 8
    for (int i = 0; i < 32; ++i) { const int kk = 2 * i + (lane >> 5); scr[kk * 33 + (lane & 31)] = src[(size_t)(k0 + kk) * ldsrc + n0 + (lane & 31)]; }
    asm volatile("s_waitcnt lgkmcnt(0)" ::: "memory");
    const int c = lane & 7;
#pragma unroll
    for (int j = 0; j < 4; ++j) { const int n = (lane >> 3) + 8 * j; const LAS float* s = scr + (8 * c) * 33 + n;
        u32x4 o; o.x = pk2(s[0 * 33], s[1 * 33]); o.y = pk2(s[2 * 33], s[3 * 33]); o.z = pk2(s[4 * 33], s[5 * 33]); o.w = pk2(s[6 * 33], s[7 * 33]);
        *(u32x4*)(dstrow0 + (size_t)n * lddst + k0 + 8 * c) = o; }
    asm volatile("s_waitcnt lgkmcnt(0)" ::: "memory");
}

__device__ __forceinline__ void phase0(KArgP pk, LAS unsigned char* lds) {
    const int tid = opaque_tid(), lane = tid & 63, wave = tid >> 6, bid = opaque_bid();
    const int G = gridDim.x, gw = bid * 8 + wave, NGW = G * 8;
    unsigned char* ws = pk->ws;
    {
        const int gt = bid * 512 + tid, NT = G * 512;
        float2* rope = (float2*)(ws + WS_ROPE);
        for (int e = gt; e < 2048 * 32; e += NT) { const int pos = e >> 5, i = e & 31;
            const float inv = exp2f(-(float)(i & 15) * 0.83048202372f);
            const float ang = (float)(i < 16 ? (pos >> 6) : (pos & 63)) * inv;
            float rev = ang * 0.15915494309f; rev -= floorf(rev);
            rope[e] = make_float2(__builtin_amdgcn_cosf(rev), __builtin_amdgcn_sinf(rev)); }
        float* sp = (float*)(ws + WS_SP);
        for (int e = gt; e < 2 * 2 * 1024; e += NT) sp[e] = 8.f * log1pf(__expf(-pk->in[I_LAM][e]));
        for (int e = gt; e < 2 * 192 * 128; e += NT) { const int j = e / (192 * 128), r = e % (192 * 128);
            ((u32x4*)(ws + WS_WDQT + (size_t)j * 2 * MiB + (size_t)832 * 1024 * 2))[r] = (u32x4){0u, 0u, 0u, 0u}; }
    }
    {
        LAS float* scr = (LAS float*)(lds + wave * 16384);
        constexpr int IT_W1 = 16 * 128, IT_W2 = 64 * 32, IT_WIN = 16 * 64, IT_SQ = 16 * 32, IT_G = 8, IT_DQ = 16 * 26, IT_UQ = 8 * 48, IT_UKV = 4 * 64;
        constexpr int N1 = 4 * IT_W1, N2 = 4 * IT_W2, N3 = 2 * IT_WIN, N4 = 2 * IT_SQ, N5 = 64 * IT_G, N6 = 2 * IT_DQ, N7 = 2 * IT_UQ, N8 = 2 * IT_UKV, N9 = 2 * IT_SQ;
        constexpr int NITEMS = N1 + N2 + N3 + N4 + N5 + N6 + N7 + N8 + N9;
        for (int it = gw; it < NITEMS; it += NGW) {
            int r = it;
            if (r < N1) { const int l = r / IT_W1, q = r % IT_W1, kb = q / 128, nb = q % 128;
                transpose_item(pk->in[I_W1] + (size_t)l * 1024 * 4096, 4096, kb * 64, nb * 32, (bf16_t*)(ws + WS_W1T) + ((size_t)l * 4096 + nb * 32) * 1024, 1024, scr, lane); continue; } r -= N1;
            if (r < N2) { const int l = r / IT_W2, q = r % IT_W2, kb = q / 32, nb = q % 32;
                transpose_item(pk->in[I_W2] + (size_t)l * 4096 * 1024, 1024, kb * 64, nb * 32, (bf16_t*)(ws + WS_W2T) + ((size_t)l * 1024 + nb * 32) * 4096, 4096, scr, lane); continue; } r -= N2;
            if (r < N3) { const int j = r / IT_WIN, q = r % IT_WIN, kb = q / 64, nb = q % 64;
                transpose_item(pk->in[I_WIN] + (size_t)j * 1024 * 2048, 2048, kb * 64, nb * 32, (bf16_t*)(ws + WS_WINT) + ((size_t)j * 2048 + nb * 32) * 1024, 1024, scr, lane); continue; } r -= N3;
            if (r < N4) { const int j = r / IT_SQ, q = r % IT_SQ, kb = q / 32, nb = q % 32;
                transpose_item(pk->in[I_WOUT] + (size_t)j * 1024 * 1024, 1024, kb * 64, nb * 32, (bf16_t*)(ws + WS_WOUTT) + ((size_t)j * 1024 + nb * 32) * 1024, 1024, scr, lane); continue; } r -= N4;
            if (r < N5) { const int mat = r / IT_G, q = r % IT_G, kb = q / 4, nb = q % 4;
                const int which = mat & 1, blk = (mat >> 1) & 7, dir = (mat >> 4) & 1, j = mat >> 5;
                const float* src = (which ? pk->in[I_WX] : pk->in[I_WA]) + (size_t)(((j * 2 + dir) * 8 + blk)) * 128 * 128;
                bf16_t* dst = (bf16_t*)(ws + WS_WGT) + ((size_t)j * 4096 + (blk * 2 + dir) * 256 + which * 128 + nb * 32) * 128;
                transpose_item(src, 128, kb * 64, nb * 32, dst, 128, scr, lane); continue; } r -= N5;
            if (r < N6) { const int j = r / IT_DQ, q = r % IT_DQ, kb = q / 26, nb = q % 26;
                transpose_item(pk->in[I_WDQ] + (size_t)j * 1024 * 832, 832, kb * 64, nb * 32, (bf16_t*)(ws + WS_WDQT) + ((size_t)j * 1024 + nb * 32) * 1024, 1024, scr, lane); continue; } r -= N6;
            if (r < N7) { const int j = r / IT_UQ, q = r % IT_UQ, kb = q / 48, nb = q % 48;
                transpose_item(pk->in[I_WUQ] + (size_t)j * 512 * 1536, 1536, kb * 64, nb * 32, (bf16_t*)(ws + WS_WUQT) + ((size_t)j * 1536 + nb * 32) * 512, 512, scr, lane); continue; } r -= N7;
            if (r < N8) { const int j = r / IT_UKV, q = r % IT_UKV, kb = q / 64, nb = q % 64;
                const int n0 = nb * 32, head = n0 >> 8, within = n0 & 255;
                bf16_t* dst = within < 128 ? (bf16_t*)(ws + WS_WUKT) + ((size_t)j * 1024 + head * 128 + within) * 256
                                           : (bf16_t*)(ws + WS_WUVT) + ((size_t)j * 1024 + head * 128 + within - 128) * 256;
                transpose_item(pk->in[I_WUKV] + (size_t)j * 256 * 2048, 2048, kb * 64, n0, dst, 256, scr, lane); continue; } r -= N8;
            { const int j = r / IT_SQ, q = r % IT_SQ, kb = q / 32, nb = q % 32;
                transpose_item(pk->in[I_WO] + (size_t)j * 1024 * 1024, 1024, kb * 64, nb * 32, (bf16_t*)(ws + WS_WOT) + ((size_t)j * 1024 + nb * 32) * 1024, 1024, scr, lane); }
        }
    }
    __syncthreads();
    {
        LAS float* sl = (LAS float*)lds;
        LAS float* red = (LAS float*)(lds + 36864);
        for (int e = tid; e < 9 * 1024; e += 512) { const int cnd = e >> 10, k = e & 1023;
            const float v = cnd == 0 ? pk->in[I_CCTX][k] : pk->in[I_C][(cnd - 1) * 1024 + k]; sl[e] = v / (1.f + __expf(-v)); }
        __syncthreads();
        float* mod = (float*)(ws + WS_MOD);
        const int half = lane >> 5, l32 = lane & 31;
        for (int unit = bid; unit < 4 * 48; unit += G) {
            const int l = unit / 48, cb = unit % 48, col = cb * 128 + l32 * 4;
            const float* w = pk->in[I_ADAW] + (size_t)l * 1024 * 6144 + col;
            f32x4 acc[9];
#pragma unroll
            for (int c = 0; c < 9; ++c) acc[c] = (f32x4){0.f, 0.f, 0.f, 0.f};
            const int kbase = wave * 128 + half;
#pragma unroll 4
            for (int i = 0; i < 64; ++i) { const int k = kbase + 2 * i; const f32x4 wv = *(const f32x4*)(w + (size_t)k * 6144);
#pragma unroll
                for (int c = 0; c < 9; ++c) acc[c] += wv * sl[c * 1024 + k]; }
            const int part = wave * 2 + half;
#pragma unroll
            for (int c = 0; c < 9; ++c)
#pragma unroll
                for (int j = 0; j < 4; ++j) red[(part * 36 + c * 4 + j) * 32 + l32] = acc[c][j];
            __syncthreads();
            for (int o = tid; o < 9 * 128; o += 512) { const int c = o >> 7, cc = o & 127, ll = cc >> 2, j = cc & 3; float s = 0.f;
#pragma unroll
                for (int pp = 0; pp < 16; ++pp) s += red[(pp * 36 + c * 4 + j) * 32 + ll];
                mod[((size_t)l * 9 + c) * 6144 + cb * 128 + cc] = s + pk->in[I_ADAB][l * 6144 + cb * 128 + cc]; }
            __syncthreads();
        }
    }
}

__device__ __forceinline__ void norm_phase(const float* x0, const float* x1, const float* gn, const float* modl, int iscale, bf16_t* H, float* ss) {
    const int tid_ = opaque_tid(), lane = tid_ & 63, gw = opaque_bid() * 8 + (tid_ >> 6), NGW = gridDim.x * 8;
    f32x4 nv[4];
    if (gw < M) { const float* xr = gw < MCTX ? x0 + (size_t)gw * D : x1 + (size_t)(gw - MCTX) * D;
#pragma unroll
        for (int j = 0; j < 4; ++j) nv[j] = *(const f32x4*)(xr + 4 * lane + 256 * j); }
    for (int row = gw; row < M; row += NGW) {
        const int cnd = row < MCTX ? 0 : 1 + ((row - MCTX) >> 11);
        const float* sc = modl + (size_t)cnd * 6144 + iscale * 1024;
        f32x4 v[4]; float sq = 0.f;
#pragma unroll
        for (int j = 0; j < 4; ++j) v[j] = nv[j];
        const int rn = row + NGW;
        if (rn < M) { const float* xr = rn < MCTX ? x0 + (size_t)rn * D : x1 + (size_t)(rn - MCTX) * D;
#pragma unroll
            for (int j = 0; j < 4; ++j) nv[j] = *(const f32x4*)(xr + 4 * lane + 256 * j); }
#pragma unroll
        for (int j = 0; j < 4; ++j) sq += (v[j][0] * v[j][0] + v[j][1] * v[j][1]) + (v[j][2] * v[j][2] + v[j][3] * v[j][3]);
        sq = wave_sum(sq, lane);
        if (lane < 16) ss[(size_t)row * 16 + lane] = lane == 0 ? sq : 0.f;
#pragma unroll
        for (int j = 0; j < 4; ++j) { const int c = 4 * lane + 256 * j;
            const f32x4 g = *(const f32x4*)(gn + c), s_ = *(const f32x4*)(sc + c);
            const f32x4 y = v[j] * g * (s_ + 1.f);
            *(u32x2*)(H + (size_t)row * D + c) = (u32x2){pk2(y[0], y[1]), pk2(y[2], y[3])}; }
    }
}
__device__ __forceinline__ void final_norm_phase(float* X, const float* gn) {
    const int tid_ = opaque_tid(), lane = tid_ & 63, gw = opaque_bid() * 8 + (tid_ >> 6), NGW = gridDim.x * 8;
    f32x4 g[4];
#pragma unroll
    for (int j = 0; j < 4; ++j) g[j] = *(const f32x4*)(gn + 4 * lane + 256 * j);
    f32x4 nv[4];
    if (gw < M) {
#pragma unroll
        for (int j = 0; j < 4; ++j) nv[j] = *(const f32x4*)(X + (size_t)gw * D + 4 * lane + 256 * j); }
    for (int row = gw; row < M; row += NGW) {
        float* xr = X + (size_t)row * D;
        f32x4 v[4]; float ss = 0.f;
#pragma unroll
        for (int j = 0; j < 4; ++j) v[j] = nv[j];
        if (row + NGW < M) {
#pragma unroll
            for (int j = 0; j < 4; ++j) nv[j] = *(const f32x4*)(xr + (size_t)NGW * D + 4 * lane + 256 * j); }
#pragma unroll
        for (int j = 0; j < 4; ++j) ss += (v[j][0] * v[j][0] + v[j][1] * v[j][1]) + (v[j][2] * v[j][2] + v[j][3] * v[j][3]);
        const float rstd = rsqrtf(wave_sum(ss, lane) * (1.f / D) + 1e-6f);
#pragma unroll
        for (int j = 0; j < 4; ++j) *(f32x4*)(xr + 4 * lane + 256 * j) = v[j] * rstd * g[j];
    }
}
__device__ __forceinline__ void conv_phase(const bf16_t* XB, bf16_t* XC, const float* cw, const float* cb) {
    const int gt = opaque_bid() * 512 + opaque_tid(), NT = gridDim.x * 512;
    for (int it = gt; it < (M / 8) * 128; it += NT) {
        const int tg = it >> 7, cgp = it & 127, ch0 = cgp * 8, r0 = tg * 8;
        const int seqlen = r0 < MCTX ? 256 : 2048; const int t0 = r0 < MCTX ? (r0 & 255) : ((r0 - MCTX) & 2047);
        float w[4][8], bias[8];
#pragma unroll
        for (int k = 0; k < 4; ++k)
#pragma unroll
            for (int j = 0; j < 8; ++j) w[k][j] = cw[k * 1024 + ch0 + j];
#pragma unroll
        for (int j = 0; j < 8; ++j) bias[j] = cb[ch0 + j];
        float acc[8][8];
#pragma unroll
        for (int t = 0; t < 8; ++t)
#pragma unroll
            for (int j = 0; j < 8; ++j) acc[t][j] = bias[j];
#pragma unroll
        for (int s = 0; s < 11; ++s) {
            const int ts = t0 - 1 + s;
            u32x4 xw = (u32x4){0u, 0u, 0u, 0u};
            if (ts >= 0 && ts < seqlen) xw = *(const u32x4*)(XB + (size_t)(r0 - 1 + s) * 1024 + ch0);
            const float xf[8] = {bflo(xw.x), bfhi(xw.x), bflo(xw.y), bfhi(xw.y), bflo(xw.z), bfhi(xw.z), bflo(xw.w), bfhi(xw.w)};
#pragma unroll
            for (int k = 0; k < 4; ++k) { const int t = s - k;
                if (t >= 0 && t < 8) {
#pragma unroll
                    for (int j = 0; j < 8; ++j) acc[t][j] += w[k][j] * xf[j]; } }
        }
#pragma unroll
        for (int t = 0; t < 8; ++t)
            *(u32x4*)(XC + (size_t)(r0 + t) * 1024 + ch0) = (u32x4){pk2(acc[t][0], acc[t][1]), pk2(acc[t][2], acc[t][3]), pk2(acc[t][4], acc[t][5]), pk2(acc[t][6], acc[t][7])};
    }
}
__device__ __forceinline__ void scan1_phase(const unsigned* AB, float* car) {
    const int gt = opaque_bid() * 512 + opaque_tid(), NT = gridDim.x * 512;
    for (int it = gt; it < 2 * 640 * 256; it += NT) {
        const int cg4 = it & 255, c = (it >> 8) % 640, dir = it / (640 * 256);
        const unsigned* ab = AB + ((size_t)dir * M + c * 32) * 1024 + cg4 * 4;
        u32x4 v[32];
#pragma unroll
        for (int s = 0; s < 32; ++s) v[s] = *(const u32x4*)(ab + (size_t)s * 1024);
        asm volatile("" ::: "memory");
        float sl[4] = {0.f, 0.f, 0.f, 0.f}, h[4] = {0.f, 0.f, 0.f, 0.f};
        if (dir == 0) {
#pragma unroll
            for (int s = 0; s < 32; ++s) { const unsigned vv[4] = {v[s].x, v[s].y, v[s].z, v[s].w};
#pragma unroll
                for (int j = 0; j < 4; ++j) { const float la = bflo(vv[j]), b = bfhi(vv[j]); h[j] = __expf(la) * h[j] + b; sl[j] += la; } }
        } else {
#pragma unroll
            for (int s = 31; s >= 0; --s) { const unsigned vv[4] = {v[s].x, v[s].y, v[s].z, v[s].w};
#pragma unroll
                for (int j = 0; j < 4; ++j) { const float la = bflo(vv[j]), b = bfhi(vv[j]); h[j] = __expf(la) * h[j] + b; sl[j] += la; } }
        }
        float* o = car + (((size_t)dir * 640 + c) * 1024 + cg4 * 4) * 2;
        *(f32x4*)o = (f32x4){sl[0], h[0], sl[1], h[1]}; *(f32x4*)(o + 4) = (f32x4){sl[2], h[2], sl[3], h[3]};
    }
}
__device__ __forceinline__ void scan2_phase(float* car, const float* state_in  , int j, float* out_state) {
    const int gt = opaque_bid() * 512 + opaque_tid(), NT = gridDim.x * 512;
    for (int it = gt; it < 2 * 24 * 1024; it += NT) {
        const int ch = it & 1023, seq = (it >> 10) % 24, dir = it / (24 * 1024);
        const int c0 = seq < 16 ? seq * 8 : 128 + (seq - 16) * 64, nc = seq < 16 ? 8 : 64;
        float h = seq < 16 ? 0.f : state_in[(((size_t)(seq - 16) * 2 + j) * 2 + dir) * 1024 + ch];
        float2* cp = (float2*)car + ((size_t)dir * 640 + c0) * 1024 + ch;
#pragma unroll 8
        for (int s = 0; s < nc; ++s) { const int c = dir ? nc - 1 - s : s; const float2 v = cp[(size_t)c * 1024];
            cp[(size_t)c * 1024].y = h; h = __expf(v.x) * h + v.y; }
        if (seq < 16) out_state[(((size_t)seq * 2 + j) * 2 + dir) * 1024 + ch] = h;
    }
}
__device__ __forceinline__ void scan3_phase(const unsigned* AB, const float* car, const bf16_t* YB, bf16_t* Gout) {
    const int gt = opaque_bid() * 512 + opaque_tid(), NT = gridDim.x * 512;
    for (int it = gt; it < 640 * 512; it += NT) {
        const int cp = it & 511, c = it >> 9, ch = cp * 2;
        const size_t rb = (size_t)c * 32 * 1024 + ch;
        u32x2 vf[32], vb[32]; unsigned yv[32];
        const f32x4 cif = *(const f32x4*)(car + (((size_t)0 * 640 + c) * 1024 + ch) * 2), cib = *(const f32x4*)(car + (((size_t)1 * 640 + c) * 1024 + ch) * 2);
#pragma unroll
        for (int t = 0; t < 32; ++t) vf[t] = *(const u32x2*)(AB + rb + (size_t)t * 1024);
#pragma unroll
        for (int t = 0; t < 32; ++t) vb[t] = *(const u32x2*)(AB + (size_t)M * 1024 + rb + (size_t)t * 1024);
#pragma unroll
        for (int t = 0; t < 32; ++t) yv[t] = *(const unsigned*)(YB + rb + (size_t)t * 1024);
        asm volatile("" ::: "memory");
        float hf[32][2];
        { float h0 = cif[1], h1 = cif[3];
#pragma unroll
          for (int t = 0; t < 32; ++t) { h0 = __expf(bflo(vf[t].x)) * h0 + bfhi(vf[t].x); h1 = __expf(bflo(vf[t].y)) * h1 + bfhi(vf[t].y); hf[t][0] = h0; hf[t][1] = h1; } }
        { float h0 = cib[1], h1 = cib[3];
#pragma unroll
          for (int t = 31; t >= 0; --t) { h0 = __expf(bflo(vb[t].x)) * h0 + bfhi(vb[t].x); h1 = __expf(bflo(vb[t].y)) * h1 + bfhi(vb[t].y);
              *(unsigned*)(Gout + rb + (size_t)t * 1024) = pk2((hf[t][0] + h0) * bflo(yv[t]), (hf[t][1] + h1) * bfhi(yv[t])); } }
    }
}
__device__ __forceinline__ int kvrow_of(int row) { return row < MCTX ? row : MCTX + ((row - MCTX) >> 11) * KVB + ((row - MCTX) & 2047); }
__device__ __forceinline__ void mla_post_phase(const float* PROJ, const float* gq, const float* gkv, const float* rope, const float* cckv, const float* ckpe, int j,
                                               bf16_t* CQ, bf16_t* CKV, bf16_t* KPE, float* out_ckv, float* out_kpe) {
    const int tid_ = opaque_tid(), lane = tid_ & 63, gw = opaque_bid() * 8 + (tid_ >> 6), NGW = gridDim.x * 8;
    for (int row = gw; row < M + 2048; row += NGW) {
        if (row < M) {
            const float* pr = PROJ + (size_t)row * 1024;
            const f32x4 a = *(const f32x4*)(pr + 4 * lane), b = *(const f32x4*)(pr + 256 + 4 * lane), cv = *(const f32x4*)(pr + 512 + 4 * lane);
            const float ssq = wave_sum((a[0] * a[0] + a[1] * a[1]) + (a[2] * a[2] + a[3] * a[3]) + (b[0] * b[0] + b[1] * b[1]) + (b[2] * b[2] + b[3] * b[3]), lane);
            const float ssk = wave_sum((cv[0] * cv[0] + cv[1] * cv[1]) + (cv[2] * cv[2] + cv[3] * cv[3]), lane);
            const float rq = rsqrtf(ssq * (1.f / 512.f) + 1e-6f), rk = rsqrtf(ssk * (1.f / 256.f) + 1e-6f);
            const f32x4 ga = *(const f32x4*)(gq + 4 * lane), gb = *(const f32x4*)(gq + 256 + 4 * lane), gk = *(const f32x4*)(gkv + 4 * lane);
            const f32x4 ya = a * rq * ga, yb = b * rq * gb, yk = cv * rk * gk;
            *(u32x2*)(CQ + (size_t)row * 512 + 4 * lane) = (u32x2){pk2(ya[0], ya[1]), pk2(ya[2], ya[3])};
            *(u32x2*)(CQ + (size_t)row * 512 + 256 + 4 * lane) = (u32x2){pk2(yb[0], yb[1]), pk2(yb[2], yb[3])};
            const int kr = kvrow_of(row);
            *(u32x2*)(CKV + (size_t)kr * 256 + 4 * lane) = (u32x2){pk2(yk[0], yk[1]), pk2(yk[2], yk[3])};
            if (row < MCTX) { const int bb = row >> 8, t = row & 255; *(f32x4*)(out_ckv + (((size_t)bb * 2 + j) * 256 + t) * 256 + 4 * lane) = yk; }
            if (lane < 32) { const f32x2 kp = *(const f32x2*)(pr + 768 + 2 * lane); float x1 = kp[0], x2 = kp[1];
                if (row < MCTX) { const int bb = row >> 8, t = row & 255; *(f32x2*)(out_kpe + (((size_t)bb * 2 + j) * 256 + t) * 64 + 2 * lane) = kp; }
                else { const int pos = (row - MCTX) & 2047; const f32x2 cs = *(const f32x2*)(rope + ((size_t)pos * 32 + lane) * 2);
                    const float o1 = x1 * cs[0] - x2 * cs[1], o2 = x1 * cs[1] + x2 * cs[0]; x1 = o1; x2 = o2; }
                *(unsigned*)(KPE + (size_t)kr * 64 + 2 * lane) = pk2(x1, x2); }
        } else {
            const int cr = row - M, bb = cr >> 8, s = cr & 255, kr = MCTX + bb * KVB + 2048 + s;
            const f32x4 cv = *(const f32x4*)(cckv + (((size_t)bb * 2 + j) * 256 + s) * 256 + 4 * lane);
            *(u32x2*)(CKV + (size_t)kr * 256 + 4 * lane) = (u32x2){pk2(cv[0], cv[1]), pk2(cv[2], cv[3])};
            if (lane < 32) { const f32x2 kp = *(const f32x2*)(ckpe + (((size_t)bb * 2 + j) * 256 + s) * 64 + 2 * lane);
                *(unsigned*)(KPE + (size_t)kr * 64 + 2 * lane) = pk2(kp[0], kp[1]); }
        }
    }
}

constexpr int AT_PE = 16384, AT_VT = 24576, ATT_BUF = 40960;
__device__ __forceinline__ void attn_phase(LAS unsigned char* lds, const bf16_t* Q, const bf16_t* KN, const bf16_t* KPE, const bf16_t* VT, bf16_t* O) {
    const int tid = opaque_tid(), lane = tid & 63, wave = __builtin_amdgcn_readfirstlane(tid >> 6), q32 = lane & 31, hi = lane >> 5;
    const int G = gridDim.x, bx = opaque_bid();
    const int xcd = bx & 7, idx = bx >> 3;
    const int pi_row = 16 * ((q32 >> 3) >> 1) + 8 * ((q32 >> 2) & 1) + 4 * ((q32 >> 3) & 1) + (q32 & 3);
    const unsigned laneN = (unsigned)(pi_row * 256 + (((pi_row & 15) ^ hi) * 16));
    const unsigned laneP = (unsigned)(AT_PE + pi_row * 128 + ((((pi_row >> 1) & 7) ^ hi) * 16));
    const unsigned laneV = (unsigned)(AT_VT + q32 * 128 + ((((q32 >> 1) & 7) ^ hi) * 16));
    const int rN = 8 * wave + (lane >> 4), cN = (lane & 15) ^ (rN & 15);
    const unsigned oN0 = (unsigned)(rN * 1024 + cN * 8) * 2u, oN1 = (unsigned)((rN + 4) * 1024 + (cN ^ 4) * 8) * 2u;
    const int rP = 8 * wave + (lane >> 3), cP = (lane & 7) ^ ((rP >> 1) & 7);
    const unsigned oP = (unsigned)(rP * 64 + cP * 8) * 2u;
    const int dV = 16 * wave + (lane >> 3), cV = (lane & 7) ^ ((dV >> 1) & 7);
    const unsigned oV0 = (unsigned)(dV * MKV + cV * 8) * 2u, oV1 = (unsigned)((dV + 8) * MKV + (cV ^ 4) * 8) * 2u;
    for (int ui = bx; ui < 512 + 128; ui += G) {
        int qrow0, kv0, ntile, h;
        if (ui < 512) {
            int bh, qb;
            if (G == 256) { const int r = ui >> 8; bh = r * 32 + xcd * 4 + (idx >> 3); qb = idx & 7; } else { bh = ui >> 3; qb = ui & 7; }
            const int b = bh >> 3; h = bh & 7; qrow0 = MCTX + b * 2048 + qb * 256; kv0 = MCTX + b * KVB; ntile = 36;
        } else { const int v = ui - 512, b = v >> 3; h = v & 7; qrow0 = b * 256; kv0 = b * 256; ntile = 4; }
        bf16x8 qf[12];
        { const char* qb_ = (const char*)(Q + (size_t)(qrow0 + wave * 32) * QW + h * 192); const unsigned qo_ = (unsigned)(q32 * QW + 8 * hi) * 2u;
#pragma unroll
          for (int ks = 0; ks < 12; ++ks) qf[ks] = *(const bf16x8*)(qb_ + 32 * ks + qo_); }
        f32x16 oacc[4];
#pragma unroll
        for (int d = 0; d < 4; ++d)
#pragma unroll
            for (int r = 0; r < 16; ++r) oacc[d][r] = 0.f;
        float m_run = -1e30f, l_run = 0.f;
        const char* bKn = (const char*)(KN + (size_t)kv0 * 1024 + h * 128);
        const char* bKp = (const char*)(KPE + (size_t)kv0 * 64);
        const char* bV = (const char*)(VT + (size_t)(h * 128) * MKV + kv0);
#define ATT_GLDS(g, l) __builtin_amdgcn_global_load_lds((const unsigned*)(g), (LAS unsigned*)(l), 16, 0, 0)
#define ATT_DMA(t, bufb) do { const char* k_ = bKn + (size_t)(t) * (64 * 1024 * 2); const char* p_ = bKp + (size_t)(t) * (64 * 64 * 2); const char* v_ = bV + (size_t)(t) * 128; \
        LAS unsigned char* d_ = lds + (bufb); \
        ATT_GLDS(k_ + oN0, d_ + (2 * wave) * 1024); ATT_GLDS(k_ + oN1, d_ + (2 * wave + 1) * 1024); ATT_GLDS(p_ + oP, d_ + AT_PE + wave * 1024); \
        ATT_GLDS(v_ + oV0, d_ + AT_VT + (2 * wave) * 1024); ATT_GLDS(v_ + oV1, d_ + AT_VT + (2 * wave + 1) * 1024); } while (0)
        asm volatile("s_waitcnt lgkmcnt(0)" ::: "memory"); __builtin_amdgcn_s_barrier(); asm volatile("" ::: "memory");
        ATT_DMA(0, 0); ATT_DMA(1, ATT_BUF);
        int bcur = 0;
        for (int t = 0; t < ntile; ++t) {
            if (t + 1 < ntile) asm volatile("s_waitcnt vmcnt(5)" ::: "memory"); else asm volatile("s_waitcnt vmcnt(0)" ::: "memory");
            asm volatile("s_waitcnt lgkmcnt(0)" ::: "memory"); __builtin_amdgcn_s_barrier(); asm volatile("" ::: "memory");
            const int bprev = bcur == 0 ? 2 * ATT_BUF : bcur - ATT_BUF;
            if (t + 2 < ntile) ATT_DMA(t + 2, bprev);
            const unsigned aN = laneN + (unsigned)bcur, aP = laneP + (unsigned)bcur, aV = laneV + (unsigned)bcur;
            bcur = bcur == 2 * ATT_BUF ? 0 : bcur + ATT_BUF;
            f32x16 s0, s1;
#pragma unroll
            for (int r = 0; r < 16; ++r) { s0[r] = 0.f; s1[r] = 0.f; }
#pragma unroll
            for (int ks = 0; ks < 12; ++ks) {
                const unsigned pa = ks < 8 ? (aN ^ (unsigned)(ks * 32)) : (aP ^ (unsigned)((ks - 8) * 32));
                const bf16x8 a0 = *(const LAS bf16x8*)(lds + pa), a1 = *(const LAS bf16x8*)(lds + pa + (ks < 8 ? 8192 : 4096));
                s0 = __builtin_amdgcn_mfma_f32_32x32x16_bf16(a0, qf[ks], s0, 0, 0, 0);
                s1 = __builtin_amdgcn_mfma_f32_32x32x16_bf16(a1, qf[ks], s1, 0, 0, 0);
            }
            float mx = s0[0];
#pragma unroll
            for (int r = 1; r < 16; ++r) mx = fmaxf(mx, s0[r]);
#pragma unroll
            for (int r = 0; r < 16; ++r) mx = fmaxf(mx, s1[r]);
            mx = fmaxf(mx, shfl_xor_l(mx, lane, 32));
            const float m_new = fmaxf(m_run, mx), alpha = __builtin_amdgcn_exp2f(m_run - m_new);
            const bool grow = __builtin_amdgcn_ballot_w64(m_new > m_run) != 0ull; m_run = m_new;
            float ls = 0.f;
#pragma unroll
            for (int r = 0; r < 16; ++r) { s0[r] = __builtin_amdgcn_exp2f(s0[r] - m_new); s1[r] = __builtin_amdgcn_exp2f(s1[r] - m_new); ls += s0[r] + s1[r]; }
            l_run = l_run * alpha + ls;
            if (grow) {
#pragma unroll
                for (int d = 0; d < 4; ++d)
#pragma unroll
                    for (int r = 0; r < 16; ++r) oacc[d][r] *= alpha;
            }
            bf16x8 pb[2][2];
#pragma unroll
            for (int jj = 0; jj < 2; ++jj) {
                u32x4 w0, w1;
                w0.x = pg8::cvt_pk_bf16(s0[8 * jj + 0], s0[8 * jj + 1]); w0.y = pg8::cvt_pk_bf16(s0[8 * jj + 2], s0[8 * jj + 3]);
                w0.z = pg8::cvt_pk_bf16(s0[8 * jj + 4], s0[8 * jj + 5]); w0.w = pg8::cvt_pk_bf16(s0[8 * jj + 6], s0[8 * jj + 7]);
                w1.x = pg8::cvt_pk_bf16(s1[8 * jj + 0], s1[8 * jj + 1]); w1.y = pg8::cvt_pk_bf16(s1[8 * jj + 2], s1[8 * jj + 3]);
                w1.z = pg8::cvt_pk_bf16(s1[8 * jj + 4], s1[8 * jj + 5]); w1.w = pg8::cvt_pk_bf16(s1[8 * jj + 6], s1[8 * jj + 7]);
                pb[0][jj] = __builtin_bit_cast(bf16x8, w0); pb[1][jj] = __builtin_bit_cast(bf16x8, w1);
            }
#pragma unroll
            for (int hf = 0; hf < 2; ++hf)
#pragma unroll
                for (int jj = 0; jj < 2; ++jj) {
                    const unsigned pv = aV ^ (unsigned)(hf * 64 + jj * 32);
#pragma unroll
                    for (int d = 0; d < 4; ++d) {
                        const bf16x8 av = *(const LAS bf16x8*)(lds + pv + d * 4096);
                        oacc[d] = __builtin_amdgcn_mfma_f32_32x32x16_bf16(av, pb[hf][jj], oacc[d], 0, 0, 0);
                    }
                }
        }
        const float lt = l_run + shfl_xor_l(l_run, lane, 32), inv = 1.f / lt;
        char* ob_ = (char*)(O + (size_t)(qrow0 + wave * 32) * 1024 + h * 128); const unsigned oo_ = (unsigned)(q32 * 1024 + 4 * hi) * 2u;
#pragma unroll
        for (int d = 0; d < 4; ++d)
#pragma unroll
            for (int g4 = 0; g4 < 4; ++g4)
                *(u32x2*)(ob_ + (d * 32 + g4 * 8) * 2 + oo_) = (u32x2){pk2(oacc[d][4 * g4 + 0] * inv, oacc[d][4 * g4 + 1] * inv), pk2(oacc[d][4 * g4 + 2] * inv, oacc[d][4 * g4 + 3] * inv)};
#undef ATT_GLDS
#undef ATT_DMA
    }
    asm volatile("s_waitcnt vmcnt(0) lgkmcnt(0)" ::: "memory"); __builtin_amdgcn_s_barrier(); asm volatile("" ::: "memory");
}

#define XB_TMO      128
#define XB_XCNT(j)  (256  + 64 * (j))
#define XB_XSUB(j)  (1280 + 64 * (j))
#define XB_XGEN(j)  (2304 + 64 * (j))
#define XB_TOP      3328
#define XB_TOPGEN   3392
#define XCD_BAR_WORDS 3456
#define XB_SPIN_CAP (1u << 22)
__device__ __forceinline__ unsigned xb_ld(unsigned* p)              { return __hip_atomic_load(p, __ATOMIC_RELAXED, __HIP_MEMORY_SCOPE_AGENT); }
__device__ __forceinline__ unsigned xb_add(unsigned* p, unsigned v) { return __hip_atomic_fetch_add(p, v, __ATOMIC_RELAXED, __HIP_MEMORY_SCOPE_AGENT); }
__device__ __forceinline__ unsigned xb_xcc_id() { return (unsigned)__builtin_amdgcn_s_getreg((3 << 11) | 20) & 0xFu; }
#define XB_SPIN(cond, bar) do { unsigned _sp = 0; while (cond) { __builtin_amdgcn_s_sleep(1); \
    if ((++_sp & 255u) == 0u) { if (xb_ld(&(bar)[XB_TMO])) break; if (_sp > XB_SPIN_CAP) { atomicAdd(&(bar)[XB_TMO], 1u); break; } } } } while (0)
struct XcdBarrier { unsigned* bar; unsigned x; volatile LAS unsigned* st; };
__device__ __forceinline__ XcdBarrier xcd_barrier_post(unsigned* bar, volatile LAS unsigned* st) {
    XcdBarrier b; b.bar = bar; b.x = xb_xcc_id(); b.st = st;
    if (threadIdx.x == 0) (void)xb_add(&bar[XB_XCNT(b.x)], 1u);
    return b;
}
__device__ __forceinline__ void xcd_barrier_complete(unsigned* bar, unsigned x, unsigned& nloc, unsigned& nx) {
    const unsigned G = gridDim.x * gridDim.y * gridDim.z;
    unsigned sum, cnt, mine, sp = 0u;
    for (;;) {
        sum = 0u; cnt = 0u; mine = 0u;
#pragma unroll
        for (unsigned j = 0; j < 16; ++j) { const unsigned c = xb_ld(&bar[XB_XCNT(j)]); sum += c; cnt += (c > 0u) ? 1u : 0u; mine = (j == x) ? c : mine; }
        if (sum == G) break;
        __builtin_amdgcn_s_sleep(1);
        if ((++sp & 255u) == 0u) { if (xb_ld(&bar[XB_TMO])) break; if (sp > XB_SPIN_CAP) { atomicAdd(&bar[XB_TMO], 1u); break; } }
    }
    nloc = mine > 0u ? mine : 1u; nx = cnt > 0u ? cnt : 1u;
}
__device__ __forceinline__ void xcd_barrier(const XcdBarrier& b) {
    asm volatile("s_waitcnt vmcnt(0)" ::: "memory");
    __syncthreads();
    if (threadIdx.x == 0) {
        unsigned* bar = b.bar;
        __builtin_amdgcn_s_waitcnt(0);
        unsigned nloc = b.st[0], nx = b.st[1];
        if (nloc == 0u) { xcd_barrier_complete(bar, b.x, nloc, nx); b.st[0] = nloc; b.st[1] = nx; }
        const unsigned old = xb_add(&bar[XB_XSUB(b.x)], 1u);
        const unsigned gen = old / nloc;
        if (old + 1u == (gen + 1u) * nloc) {
            __builtin_amdgcn_fence(__ATOMIC_RELEASE, "agent");
            asm volatile("s_waitcnt vmcnt(0)" ::: "memory");
            const unsigned og = xb_add(&bar[XB_TOP], 1u);
            const unsigned tg = og / nx;
            if (og + 1u == (tg + 1u) * nx) xb_add(&bar[XB_TOPGEN], 1u);
            else XB_SPIN(xb_ld(&bar[XB_TOPGEN]) == tg, bar);
            __builtin_amdgcn_fence(__ATOMIC_ACQUIRE, "agent");
            xb_add(&bar[XB_XGEN(b.x)], 1u);
            asm volatile("s_waitcnt vmcnt(0)" ::: "memory");
        } else {
            XB_SPIN(xb_ld(&bar[XB_XGEN(b.x)]) == gen, bar);
            __builtin_amdgcn_fence(__ATOMIC_ACQUIRE, "agent");
            asm volatile("s_waitcnt vmcnt(0)" ::: "memory");
        }
    }
    __syncthreads();
}

constexpr int N_PHASES = 39;
__global__ void __launch_bounds__(512, 2) fwd_kernel(Params p) {
    extern __shared__ __attribute__((aligned(16))) unsigned char lds_raw[];
    LAS unsigned char* lds = (LAS unsigned char*)lds_raw;
    cg::grid_group grid = cg::this_grid();
    const int lo = p.ph_lo, hi = p.ph_hi;
    int k = 0, l = 0;
    if (threadIdx.x < 16) ((LAS unsigned*)(lds + 131072))[threadIdx.x] = 0u;
    __syncthreads();
    XcdBarrier xbar = xcd_barrier_post((unsigned*)(p.ws + WS_BAR), (volatile LAS unsigned*)(lds + 131072));
#ifndef EN_MASK
#define EN_MASK 0xFFFFFFFFu
#endif
#define PH_BEGIN(id) if (((EN_MASK >> (id)) & 1u) && k >= lo && k < hi) { KArgP q = opaque_kernarg(); unsigned char* ws = q->ws; float* X = q->out; \
        const int j = l >> 1; const float* modl = (const float*)(ws + WS_MOD) + (size_t)l * 9 * 6144; const float* rope = (const float*)(ws + WS_ROPE); bf16_t* H = (bf16_t*)(ws + WS_H); \
        const float* xb0 = l == 0 ? q->in[I_XP] : X; const float* xb1 = l == 0 ? q->in[I_XS] : X + (size_t)MCTX * D; \
        bf16_t* XB = (bf16_t*)(ws + S_XB); bf16_t* YB = (bf16_t*)(ws + S_YB); bf16_t* XC = (bf16_t*)(ws + S_XC); unsigned* AB = (unsigned*)(ws + S_AB); float* car = (float*)(ws + S_CAR); \
        float* PROJ = (float*)(ws + S_PROJ); bf16_t* CQ = (bf16_t*)(ws + S_CQ); bf16_t* CKV = (bf16_t*)(ws + S_CKV); bf16_t* KPE = (bf16_t*)(ws + S_KPE); \
        bf16_t* Qb = (bf16_t*)(ws + S_Q); bf16_t* KN = (bf16_t*)(ws + S_KN); bf16_t* VT = (bf16_t*)(ws + S_VT); bf16_t* A2 = (bf16_t*)(ws + S_A2); \
        float* SS = (float*)(ws + WS_SS); const float* SWl = (const float*)(ws + WS_SW) + (size_t)l * 9 * 6144; bf16_t* OB = (bf16_t*)(ws + S_O); LAS float* RS = (LAS float*)(lds + 131072); (void)SS; (void)SWl; (void)OB; (void)RS; \
        (void)j; (void)modl; (void)rope; (void)H; (void)xb0; (void)xb1; (void)XB; (void)YB; (void)XC; (void)AB; (void)car; (void)PROJ; (void)CQ; (void)CKV; (void)KPE; (void)Qb; (void)KN; (void)VT; (void)A2; (void)X;
#define PH_END   if (k + 1 < hi) { if (hi < 0) grid.sync();   xcd_barrier(xbar); } } ++k;

    PH_BEGIN(0) phase0(q, lds); PH_END

    for (l = 0; l < 4; ++l) {
        if (l == 0) { PH_BEGIN(1) norm_phase(xb0, xb1, q->in[I_NMIX], modl, 1, H, SS); sw_phase((const float*)(ws + WS_MOD), ws, (float*)(ws + WS_SW)); PH_END }
        if ((l & 1) == 0) {
            PH_BEGIN(2) { EpiBf16<2, true> E{XB, YB, 1024, SS, SWl}; run_gemm(lds, H, 1024, (const bf16_t*)(ws + WS_WINT) + (size_t)j * 2048 * 1024, 1024, M, 2048, 1024, 0, 0, E); } PH_END
            PH_BEGIN(3) conv_phase(XB, XC, q->in[I_CONVW] + j * 4096, q->in[I_CONVB] + j * 1024); PH_END
            PH_BEGIN(4) { EpiGates E{XC, AB, q->in[I_BA] + j * 2048, q->in[I_BX] + j * 2048, (const float*)(ws + WS_SP) + j * 2048};
                       run_gemm(lds, XC, 1024, (const bf16_t*)(ws + WS_WGT) + (size_t)j * 4096 * 128, 128, M, 4096, 128, 1, 256, E); } PH_END
            PH_BEGIN(5) scan1_phase(AB, car); PH_END
            PH_BEGIN(6) scan2_phase(car, q->in[I_STATE], j, X + OUT_STATE); PH_END
            PH_BEGIN(7) scan3_phase(AB, car, YB, YB); PH_END
            PH_BEGIN(8) { EpiResid E{xb0, xb1, X, modl + 2 * 1024, H, q->in[I_NMLP] + l * 1024, modl + 4 * 1024, SS};
                       run_gemm(lds, YB, 1024, (const bf16_t*)(ws + WS_WOUTT) + (size_t)j * 1024 * 1024, 1024, M, 1024, 1024, 0, 0, E); } PH_END
        } else {
            PH_BEGIN(9) { EpiF32 E{PROJ, 1024, SS, SWl}; run_gemm(lds, H, 1024, (const bf16_t*)(ws + WS_WDQT) + (size_t)j * 1024 * 1024, 1024, M, 1024, 1024, 0, 0, E); } PH_END
            PH_BEGIN(10) mla_post_phase(PROJ, q->in[I_NQ] + j * 512, q->in[I_NKV] + j * 256, rope, q->in[I_CCKV], q->in[I_CKPE], j, CQ, CKV, KPE, X + OUT_CKV, X + OUT_KPE); PH_END
            PH_BEGIN(11) { EpiQ EQ{Qb, rope, 0.07216878364870322f * 1.4426950408889634f};
                       run_gemm(lds, CQ, 512, (const bf16_t*)(ws + WS_WUQT) + (size_t)j * 1536 * 512, 512, M, 1536, 512, 0, 0, EQ);
                       EpiDual EKV{KN, 1024, VT, MKV};
                       run_gemm_dual(lds, CKV, (const bf16_t*)(ws + WS_WUKT) + (size_t)j * 1024 * 256, MKV, 1024,
                                     (const bf16_t*)(ws + WS_WUVT) + (size_t)j * 1024 * 256, CKV, 1024, MKV, 256, 256, EKV); } PH_END
            PH_BEGIN(12) attn_phase(lds, Qb, KN, KPE, VT, OB); PH_END
            PH_BEGIN(13) { EpiResid E{xb0, xb1, X, modl + 2 * 1024, H, q->in[I_NMLP] + l * 1024, modl + 4 * 1024, SS};
                       run_gemm(lds, OB, 1024, (const bf16_t*)(ws + WS_WOT) + (size_t)j * 1024 * 1024, 1024, M, 1024, 1024, 0, 0, E); } PH_END
        }
        PH_BEGIN(15) { EpiBf16<1, true> E{A2, nullptr, 4096, SS, SWl + 2048}; run_gemm(lds, H, 1024, (const bf16_t*)(ws + WS_W1T) + (size_t)l * 4096 * 1024, 1024, M, 4096, 1024, 0, 0, E); } PH_END
        PH_BEGIN(16) { const int G_ = (int)gridDim.x; const bool split = (G_ == 256);
                       EpiResid E{X, X + (size_t)MCTX * D, X, modl + 5 * 1024, l < 3 ? H : nullptr, q->in[I_NMIX] + (l + 1) * 1024, modl + 9 * 6144 + 1024, SS};
                       const bf16_t* W2 = (const bf16_t*)(ws + WS_W2T) + (size_t)l * 1024 * 4096;
                       run_gemm(lds, A2, 4096, W2, 4096, M, 1024, 4096, 0, 0, E, split ? 256 : (1 << 30));
                       if (split) { EpiPartial EP{(float*)(ws + S_PART), 256, 80, 4}; run_gemm_split(lds, A2, 4096, W2, 4096, M, 1024, 1024, 256, EP); } } PH_END
        PH_BEGIN(17) { if ((int)gridDim.x == 256) split_reduce_phase((const float*)(ws + S_PART), X, modl + 5 * 1024, 256, 80, 4, l < 3 ? H : nullptr, q->in[I_NMIX] + (l + 1) * 1024, modl + 9 * 6144 + 1024, SS); } PH_END
    }
    PH_BEGIN(18) final_norm_phase(X, q->in[I_FN]); PH_END
#undef PH_BEGIN
#undef PH_END
}

#ifndef MULTI_LAUNCH
#define MULTI_LAUNCH 0
#endif
extern "C" void kernel_launch(void* const* d_in, const int* in_sizes, int n_in, void* d_out, int out_size, void* d_ws, size_t ws_size, hipStream_t stream) {
    static int grid = 0;
    if (grid == 0) {
        int dev = 0, cus = 0, per_cu = 0;
        hipGetDevice(&dev);
        hipDeviceGetAttribute(&cus, hipDeviceAttributeMultiprocessorCount, dev);
        hipFuncSetAttribute((const void*)fwd_kernel, hipFuncAttributeMaxDynamicSharedMemorySize, LDS_BYTES);
        hipOccupancyMaxActiveBlocksPerMultiprocessor(&per_cu, (const void*)fwd_kernel, 512, LDS_BYTES);
        if (per_cu < 1) per_cu = 1;
        grid = cus * 1;
        if (ws_size < WS_END || n_in != 29) { fprintf(stderr, "kernel_launch: ws_size %zu < %zu or n_in %d != 29\n", ws_size, (size_t)WS_END, n_in); }
        (void)hipGetLastError();
    }
    (void)hipMemsetAsync((char*)d_ws + WS_BAR, 0, BAR_BYTES, stream);
    Params p{};
    for (int i = 0; i < 29; ++i) p.in[i] = (const float*)d_in[i];
    p.out = (float*)d_out; p.ws = (unsigned char*)d_ws;
#if MULTI_LAUNCH
    for (int k = 0; k < N_PHASES; ++k) { p.ph_lo = k; p.ph_hi = k + 1; hipLaunchKernelGGL(fwd_kernel, dim3(grid), dim3(512), LDS_BYTES, stream, p); }
#else
    p.ph_lo = 0; p.ph_hi = N_PHASES;
    void* args[] = {&p};
    hipError_t e = hipLaunchCooperativeKernel((const void*)fwd_kernel, dim3(grid), dim3(512), args, LDS_BYTES, stream);
    if (e != hipSuccess) fprintf(stderr, "cooperative launch failed: %s (grid %d)\n", hipGetErrorString(e), grid);
#endif
}
```

```cpp
#include <hip/hip_runtime.h>
#include <hip/hip_cooperative_groups.h>
#include <cstdio>
#include <cstdint>
namespace cg = cooperative_groups;

#define LAS __attribute__((address_space(3)))
typedef unsigned short bf16_t;
typedef short bf16x8 __attribute__((ext_vector_type(8)));
typedef float f32x4 __attribute__((ext_vector_type(4)));
typedef float f32x2 __attribute__((ext_vector_type(2)));
typedef float f32x16 __attribute__((ext_vector_type(16)));
typedef unsigned u32x4 __attribute__((ext_vector_type(4)));
typedef unsigned u32x2 __attribute__((ext_vector_type(2)));

constexpr int D = 1024, MCTX = 4096, M = 20480, FF = 4096, MKV = 22528, KVB = 2304;
constexpr int QW = 1536;
constexpr size_t MiB = 1u << 20;
constexpr size_t WS_MOD = 0, WS_ROPE = 1 * MiB, WS_SP = 1 * MiB + 512 * 1024, WS_BAR = 1 * MiB + 768 * 1024, BAR_BYTES = 16384;
constexpr size_t WS_W1T = 2 * MiB, WS_W2T = 34 * MiB, WS_WINT = 66 * MiB, WS_WGT = 74 * MiB, WS_WOUTT = 76 * MiB, WS_WDQT = 80 * MiB,
                 WS_WUQT = 84 * MiB, WS_WUKT = 87 * MiB, WS_WUVT = 88 * MiB, WS_WOT = 89 * MiB;
constexpr size_t WS_SW = 93 * MiB, WS_SS = 94 * MiB, WS_H = 96 * MiB, WS_S = 136 * MiB, WS_END = 384 * MiB;
constexpr size_t S_A2 = WS_S, S_PART = WS_S + 160 * MiB;
constexpr size_t S_YB = WS_S, S_XC = WS_S + 40 * MiB, S_AB = WS_S + 80 * MiB, S_XB = S_AB, S_CAR = S_XC, S_G = S_YB;
constexpr size_t S_PROJ = WS_S, S_CQ = WS_S + 80 * MiB, S_CKV = WS_S + 100 * MiB, S_KPE = WS_S + 111 * MiB, S_Q = WS_S + 114 * MiB,
                 S_KN = WS_S + 174 * MiB, S_VT = WS_S, S_O = WS_S + 44 * MiB;
static_assert(S_KN + (size_t)MKV * 1024 * 2 <= WS_END && S_AB + 160 * MiB <= WS_END && S_O + 40 * MiB <= S_CKV && S_VT + 44 * MiB <= S_O, "ws map");
constexpr size_t OUT_STATE = (size_t)M * D, OUT_CKV = OUT_STATE + 65536, OUT_KPE = OUT_CKV + 2097152;

constexpr int LDS_BYTES = 147456;

__device__ __forceinline__ unsigned f2bf(float f) { unsigned u = __builtin_bit_cast(unsigned, f); return (u + 0x7fffu + ((u >> 16) & 1u)) >> 16; }
__device__ __forceinline__ unsigned pk2(float lo, float hi) { unsigned r; asm volatile("v_cvt_pk_bf16_f32 %0, %1, %2" : "=v"(r) : "v"(lo), "v"(hi)); return r; }
__device__ __forceinline__ float bflo(unsigned u) { return __builtin_bit_cast(float, u << 16); }
__device__ __forceinline__ float bfhi(unsigned u) { return __builtin_bit_cast(float, u & 0xffff0000u); }
__device__ __forceinline__ float shfl_xor_l(float v, int lane, int o) { return __builtin_bit_cast(float, __builtin_amdgcn_ds_bpermute((lane ^ o) << 2, __builtin_bit_cast(int, v))); }
__device__ __forceinline__ float wave_sum(float v, int lane) {
#pragma unroll
    for (int o = 1; o < 64; o <<= 1) v += shfl_xor_l(v, lane, o);
    return v;
}
struct Params;
typedef const __attribute__((address_space(4))) Params* KArgP;
__device__ __forceinline__ KArgP opaque_kernarg() { auto q = __builtin_amdgcn_kernarg_segment_ptr(); asm volatile("" : "+s"(q)); return (KArgP)q; }
__device__ __forceinline__ int opaque_tid() { int t = threadIdx.x; asm volatile("" : "+v"(t)); return t; }
__device__ __forceinline__ int opaque_bid() { int b = blockIdx.x; asm volatile("" : "+s"(b)); return b; }
__device__ __forceinline__ float sigmoidf_(float x) { return __builtin_amdgcn_rcpf(1.f + __expf(-x)); }
__device__ __forceinline__ int cond_of_tile(int pm) { return pm < 16 ? 0 : 1 + ((pm - 16) >> 3); }

namespace pg8 {
constexpr int BM = 256, BK = 64, HALF = 128, HTB = HALF * BK * 2, STAGE_BYTES = 8 * HTB, NXCD = 8, WGM = 8;
__host__ __device__ __forceinline__ int lds_byte(int r, int c) { const int st = (r >> 4) * 2 + (c >> 5), rr = r & 15, cc = c & 31, ob = rr * 64 + cc * 2; return st * 1024 + (ob ^ (((ob >> 9) & 1) << 5)); }
__host__ __device__ __forceinline__ void stage_rc(int b, int& R, int& C) { const int st = b / 1024, sb = b % 1024, swz = sb ^ (((sb >> 9) & 1) << 5); R = (st >> 1) * 16 + swz / 64; C = (st & 1) * 32 + (swz % 64) / 2; }
__host__ __device__ __forceinline__ int perm32(int rho) { const int n = rho >> 4, i = rho & 15; return 8 * (i >> 2) + 4 * n + (i & 3); }

struct Unit { int pm, pn, kq, idx, which; };
struct Gemm { const bf16_t* A; const bf16_t* Bt; int lda, ldb, K, a_sh, a_colbytes, kq_bytes; const bf16_t* A2; const bf16_t* Bt2; };

__device__ __forceinline__ void unit_of(int wgid, int nM, int nN, Unit& u) {
    const int nwg = nM * nN;
    { const int q = nwg / NXCD, r = nwg % NXCD, xcd = wgid % NXCD, off = wgid / NXCD; wgid = (xcd < r ? xcd * (q + 1) : r * (q + 1) + (xcd - r) * q) + off; }
    const int nig = WGM * nN, gid = wgid / nig, fm = gid * WGM, gsz = (nM - fm) < WGM ? (nM - fm) : WGM;
    u.pm = fm + ((wgid % nig) % gsz); u.pn = (wgid % nig) / gsz; u.kq = 0; u.which = 0;
}
struct StaticOrder {
    int nM, nN, lim, G, c;
    __device__ void init(int M_, int N_, int G_, int c_) { nM = M_ / BM; nN = N_ / BM; lim = nM * nN; G = G_; c = c_; }
    __device__ bool next(int i, Unit& u) const {
        const long L = (long)i * G + c; if (L >= lim) return false;
        unit_of((int)L, nM, nN, u); u.idx = i; return true;
    }
};
struct DualOrder {
    int nM0, nN0, nM1, nN1, G, c;
    __device__ bool next(int i, Unit& u) const {
        const long L = (long)i * G + c; const int n1 = nM0 * nN0;
        if (L >= n1 + nM1 * nN1) return false;
        if (L < n1) unit_of((int)L, nM0, nN0, u); else { unit_of((int)L - n1, nM1, nN1, u); u.which = 1; }
        u.idx = i; return true;
    }
};
struct SplitOrder {
    int nM, nN, base, c;
    __device__ bool next(int i, Unit& u) const {
        if (i > 0) return false; const int L = base + (c >> 2); if (L >= nM * nN) return false;
        unit_of(L, nM, nN, u); u.kq = c & 3; u.idx = 0; return true;
    }
};

__device__ __forceinline__ unsigned cvt_pk_bf16(float lo, float hi) { unsigned r; asm volatile("v_cvt_pk_bf16_f32 %0, %1, %2" : "=v"(r) : "v"(lo), "v"(hi)); return r; }

template <class Epi, class Sched, bool ALIGN_EPI = false, bool SP2 = false>
__device__ __forceinline__ void gemm_phase(LAS unsigned char* lds, const Gemm g, const Sched& S, const Epi& E) {
    const int tid = opaque_tid(), wid = __builtin_amdgcn_readfirstlane(tid >> 6), lane = tid & 63, wr = wid >> 2, wc = wid & 3, fr = lane & 15, fq = lane >> 4;
    int K_ = g.K; asm volatile("" : "+s"(K_)); const int K = K_, nt = K / BK;
    unsigned voffA[2], voffB[2];
#pragma unroll
    for (int i = 0; i < 2; ++i) { int R, C; stage_rc(tid * 16 + i * 8192, R, C); const int Rb = Epi::PERM ? ((R & ~31) + perm32(R & 31)) : R;
        voffA[i] = (unsigned)(R * g.lda + C) * 2u; voffB[i] = (unsigned)(Rb * g.ldb + C) * 2u; }
    const size_t kstep = (size_t)(BK * 2);
    const size_t hA = (size_t)HALF * g.lda * 2, hB = (size_t)HALF * g.ldb * 2;
    const size_t tA = 2 * hA, tB = 2 * hB;
    const unsigned ldsw = (unsigned)wid * 1024u;
    const int aoff = lds_byte(wr * 64 + fr, fq * 8), boff = lds_byte(wc * 32 + fr, fq * 8);
#define PG8_SA(b, h) (((b) * 2 + (h)) * HTB)
#define PG8_SB(b, h) ((4 + (b) * 2 + (h)) * HTB)
#define PG8_STAGE(bufoff, gbase, voff) do { const char* _gb = (const char*)(gbase); asm volatile("" : "+s"(_gb)); _Pragma("unroll") for (int _i = 0; _i < 2; ++_i) \
        __builtin_amdgcn_global_load_lds((const unsigned*)(_gb + (voff)[_i]), (LAS unsigned*)(lds + (bufoff) + ldsw + _i * 8192), 16, 0, 0); } while (0)
#define PG8_LDA(dst, b, h) do { _Pragma("unroll") for (int m = 0; m < 4; ++m) _Pragma("unroll") for (int k = 0; k < 2; ++k) dst[m][k] = *(const LAS bf16x8*)(lds + PG8_SA(b, h) + aoff + m * 2048 + k * 1024); } while (0)
#define PG8_LDB(dst, b, h) do { _Pragma("unroll") for (int n = 0; n < 2; ++n) _Pragma("unroll") for (int k = 0; k < 2; ++k) dst[n][k] = *(const LAS bf16x8*)(lds + PG8_SB(b, h) + boff + n * 2048 + k * 1024); } while (0)
#define PG8_MMA(ai, bj, At, Bt) do { __builtin_amdgcn_s_setprio(1); _Pragma("unroll") for (int m = 0; m < 4; ++m) _Pragma("unroll") for (int n = 0; n < 2; ++n) _Pragma("unroll") for (int k = 0; k < 2; ++k) \
        acc[ai][bj][m][n] = __builtin_amdgcn_mfma_f32_16x16x32_bf16(Bt[n][k], At[m][k], acc[ai][bj][m][n], 0, 0, 0); __builtin_amdgcn_s_setprio(0); } while (0)
#define PG8_WAIT_V(n) asm volatile("s_waitcnt vmcnt(" #n ")" ::: "memory")
#define PG8_WAIT_L(n) asm volatile("s_waitcnt lgkmcnt(" #n ")" ::: "memory")
#define PG8_BAR __builtin_amdgcn_s_barrier()
#define PG8_SCHED __builtin_amdgcn_sched_barrier(0)
#define PG8_OFFA(u) ((size_t)(u).pm * tA + (size_t)((u).pn >> g.a_sh) * (size_t)g.a_colbytes + (size_t)(u).kq * (size_t)g.kq_bytes)
#define PG8_OFFB(u) ((size_t)(u).pn * tB + (size_t)(u).kq * (size_t)g.kq_bytes)
    Unit cur, nxt; int ui = 0;
    if (!S.next(0, cur)) return;
    f32x4 acc[2][2][4][2];
#pragma unroll
    for (int a = 0; a < 2; ++a)
#pragma unroll
        for (int b = 0; b < 2; ++b)
#pragma unroll
            for (int m = 0; m < 4; ++m)
#pragma unroll
                for (int n = 0; n < 2; ++n) acc[a][b][m][n] = (f32x4){0.f, 0.f, 0.f, 0.f};
    bf16x8 At[4][2], B0[2][2], B1[2][2];
    const char* cA = (const char*)(cur.which ? g.A2 : g.A) + PG8_OFFA(cur); const char* cB = (const char*)(cur.which ? g.Bt2 : g.Bt) + PG8_OFFB(cur);
    if constexpr (SP2) {
        PG8_STAGE(PG8_SB(0, 0), cB, voffB); PG8_STAGE(PG8_SB(0, 1), cB + hB, voffB); PG8_STAGE(PG8_SA(0, 0), cA, voffA); PG8_STAGE(PG8_SA(0, 1), cA + hA, voffA);
        if (wr == 1) PG8_BAR;
        PG8_WAIT_V(2); PG8_BAR;
        PG8_STAGE(PG8_SB(1, 0), cB + kstep, voffB); PG8_STAGE(PG8_SA(1, 0), cA + kstep, voffA); PG8_STAGE(PG8_SB(1, 1), cB + hB + kstep, voffB);
        PG8_WAIT_V(6); PG8_BAR;
    } else {
        PG8_STAGE(PG8_SB(0, 0), cB, voffB); PG8_STAGE(PG8_SA(0, 0), cA, voffA); PG8_STAGE(PG8_SB(0, 1), cB + hB, voffB); PG8_STAGE(PG8_SA(0, 1), cA + hA, voffA);
        if (wr == 1) PG8_BAR;
        PG8_WAIT_V(4); PG8_BAR;
        PG8_STAGE(PG8_SB(1, 0), cB + kstep, voffB); PG8_STAGE(PG8_SA(1, 0), cA + kstep, voffA); PG8_STAGE(PG8_SB(1, 1), cB + hB + kstep, voffB);
        PG8_WAIT_V(6); PG8_BAR;
    }
    for (;;) {
        const bool has_next = S.next(ui + 1, nxt);
        const char* nA = has_next ? (const char*)(nxt.which ? g.A2 : g.A) + PG8_OFFA(nxt) : cA; const char* nB = has_next ? (const char*)(nxt.which ? g.Bt2 : g.Bt) + PG8_OFFB(nxt) : cB;
        for (int t = 0; t < nt; t += 2) {
            const bool last = (t == nt - 2);
            const char* a1 = cA + (size_t)(t + 1) * kstep;
            const char* a2 = last ? nA : cA + (size_t)(t + 2) * kstep; const char* b2 = last ? nB : cB + (size_t)(t + 2) * kstep;
            const char* a3 = a2 + kstep; const char* b3 = b2 + kstep;
            if constexpr (SP2) {
            PG8_LDB(B0, 0, 0); PG8_LDB(B1, 0, 1); PG8_SCHED; PG8_LDA(At, 0, 0); PG8_STAGE(PG8_SA(1, 1), a1 + hA, voffA);
            PG8_WAIT_V(8); PG8_WAIT_L(0); PG8_BAR; PG8_MMA(0, 0, At, B0); PG8_MMA(0, 1, At, B1); PG8_BAR; PG8_SCHED;
            PG8_LDA(At, 0, 1); PG8_STAGE(PG8_SB(0, 0), b2, voffB); PG8_STAGE(PG8_SB(0, 1), b2 + hB, voffB); PG8_STAGE(PG8_SA(0, 0), a2, voffA);
            PG8_WAIT_V(8); PG8_WAIT_L(0); PG8_BAR; PG8_MMA(1, 0, At, B0); PG8_MMA(1, 1, At, B1); PG8_BAR; PG8_SCHED;
            PG8_LDB(B0, 1, 0); PG8_LDB(B1, 1, 1); PG8_SCHED; PG8_LDA(At, 1, 0); PG8_STAGE(PG8_SA(0, 1), a2 + hA, voffA);
            PG8_WAIT_V(8); PG8_WAIT_L(0); PG8_BAR; PG8_MMA(0, 0, At, B0); PG8_MMA(0, 1, At, B1); PG8_BAR; PG8_SCHED;
            PG8_LDA(At, 1, 1); PG8_STAGE(PG8_SB(1, 0), b3, voffB); PG8_STAGE(PG8_SB(1, 1), b3 + hB, voffB); PG8_STAGE(PG8_SA(1, 0), a3, voffA);
            PG8_WAIT_V(8); PG8_WAIT_L(0); PG8_BAR; PG8_MMA(1, 0, At, B0); PG8_MMA(1, 1, At, B1); PG8_BAR; PG8_SCHED;
            } else {
            PG8_LDB(B0, 0, 0); PG8_SCHED; PG8_LDA(At, 0, 0); PG8_STAGE(PG8_SA(1, 1), a1 + hA, voffA);
            PG8_WAIT_L(8); PG8_BAR; PG8_WAIT_L(0); PG8_MMA(0, 0, At, B0); PG8_BAR; PG8_SCHED;
            PG8_LDB(B1, 0, 1); PG8_STAGE(PG8_SB(0, 0), b2, voffB);
            PG8_BAR; PG8_WAIT_L(0); PG8_MMA(0, 1, At, B1); PG8_BAR;
            PG8_LDA(At, 0, 1); PG8_STAGE(PG8_SA(0, 0), a2, voffA);
            PG8_BAR; PG8_WAIT_L(0); PG8_MMA(1, 0, At, B0); PG8_BAR; PG8_SCHED;
            PG8_STAGE(PG8_SB(0, 1), b2 + hB, voffB);
            PG8_WAIT_V(6); PG8_BAR; PG8_MMA(1, 1, At, B1); PG8_BAR;
            PG8_LDB(B0, 1, 0); PG8_SCHED; PG8_LDA(At, 1, 0); PG8_STAGE(PG8_SA(0, 1), a2 + hA, voffA);
            PG8_WAIT_L(8); PG8_BAR; PG8_WAIT_L(0); PG8_MMA(0, 0, At, B0); PG8_BAR; PG8_SCHED;
            PG8_LDB(B1, 1, 1); PG8_STAGE(PG8_SB(1, 0), b3, voffB);
            PG8_BAR; PG8_WAIT_L(0); PG8_MMA(0, 1, At, B1); PG8_BAR;
            PG8_LDA(At, 1, 1); PG8_STAGE(PG8_SA(1, 0), a3, voffA);
            PG8_BAR; PG8_WAIT_L(0); PG8_MMA(1, 0, At, B0); PG8_BAR; PG8_SCHED;
            PG8_STAGE(PG8_SB(1, 1), b3 + hB, voffB);
            PG8_WAIT_V(6); PG8_BAR; PG8_MMA(1, 1, At, B1); PG8_BAR;
            }
        }
        if constexpr (ALIGN_EPI) { if (wr == 0) PG8_BAR; }
        { int t2 = threadIdx.x; asm volatile("" : "+v"(t2)); const int w2 = t2 >> 6, l2 = t2 & 63; E(acc, cur, w2 >> 2, w2 & 3, l2 & 15, l2 >> 4); }
        if (!has_next) break;
#pragma unroll
        for (int a = 0; a < 2; ++a)
#pragma unroll
            for (int b = 0; b < 2; ++b)
#pragma unroll
                for (int m = 0; m < 4; ++m)
#pragma unroll
                    for (int n = 0; n < 2; ++n) acc[a][b][m][n] = (f32x4){0.f, 0.f, 0.f, 0.f};
        cur = nxt; cA = nA; cB = nB; ++ui;
        if constexpr (ALIGN_EPI) { if (wr == 1) PG8_BAR; }
    }
    PG8_WAIT_V(0);
    if constexpr (!ALIGN_EPI) { if (wr == 0) PG8_BAR; }
    PG8_BAR;
#undef PG8_SA
#undef PG8_SB
#undef PG8_STAGE
#undef PG8_LDA
#undef PG8_LDB
#undef PG8_MMA
#undef PG8_WAIT_V
#undef PG8_WAIT_L
#undef PG8_BAR
#undef PG8_SCHED
#undef PG8_OFFA
#undef PG8_OFFB
}
}

typedef f32x4 AccT[2][2][4][2];

template <int MODE, bool NORM = false> struct EpiBf16 {
    static constexpr bool PERM = true;
    bf16_t* O; bf16_t* O2; int ldc; const float* ss; const float* sw;
    __device__ __forceinline__ void operator()(const AccT& acc, const pg8::Unit& u, int wr, int wc, int fr, int fq) const {
        const int row0 = u.pm * 256 + wr * 64 + fr; int colt = u.pn * 256; bf16_t* base = O; bool act = (MODE == 1);
        if (MODE == 2) { if (colt >= 1024) { colt -= 1024; base = O2; act = true; } }
        const int col0 = colt + wc * 32 + 8 * fq;
        f32x4 sv[2][2];
        if (NORM) { const float* swp = sw + (size_t)cond_of_tile(u.pm) * 6144 + u.pn * 256 + wc * 32 + 8 * fq;
#pragma unroll
            for (int bj = 0; bj < 2; ++bj) { sv[bj][0] = *(const f32x4*)(swp + bj * 128); sv[bj][1] = *(const f32x4*)(swp + bj * 128 + 4); } }
        float rsd[2][4];
        if (NORM) { f32x4 t[2][4]; const int lane = fq * 16 + fr;
#pragma unroll
            for (int ai = 0; ai < 2; ++ai)
#pragma unroll
                for (int m = 0; m < 4; ++m) t[ai][m] = *(const f32x4*)(ss + (size_t)(row0 + ai * 128 + m * 16) * 16 + 4 * fq);
#pragma unroll
            for (int ai = 0; ai < 2; ++ai)
#pragma unroll
                for (int m = 0; m < 4; ++m) { float q = (t[ai][m][0] + t[ai][m][1]) + (t[ai][m][2] + t[ai][m][3]); q += shfl_xor_l(q, lane, 16); q += shfl_xor_l(q, lane, 32);
                    rsd[ai][m] = rsqrtf(q * (1.f / 1024.f) + 1e-6f); } }
#pragma unroll
        for (int ai = 0; ai < 2; ++ai)
#pragma unroll
            for (int m = 0; m < 4; ++m) { const int row = row0 + ai * 128 + m * 16; bf16_t* rowp = base + (size_t)row * ldc + col0;
                float rstd = 1.f;
                if (NORM) rstd = rsd[ai][m];
#pragma unroll
                for (int bj = 0; bj < 2; ++bj) { f32x4 v0 = acc[ai][bj][m][0], v1 = acc[ai][bj][m][1];
                    if (NORM) { v0 = v0 * rstd + sv[bj][0]; v1 = v1 * rstd + sv[bj][1]; }
                    if (act) {
#pragma unroll
                        for (int j = 0; j < 4; ++j) {
                            if (MODE == 1) { float a = fmaxf(v0[j], 0.f), b = fmaxf(v1[j], 0.f); v0[j] = a * a; v1[j] = b * b; }
                            else { float x = v0[j], y = v1[j];
                                   float ux = 1.5957691216f * (x + 0.044715f * x * x * x), uy = 1.5957691216f * (y + 0.044715f * y * y * y);
                                   v0[j] = x * __builtin_amdgcn_rcpf(1.f + __expf(-ux)); v1[j] = y * __builtin_amdgcn_rcpf(1.f + __expf(-uy)); }
                        }
                    }
                    u32x4 w; w.x = pg8::cvt_pk_bf16(v0[0], v0[1]); w.y = pg8::cvt_pk_bf16(v0[2], v0[3]); w.z = pg8::cvt_pk_bf16(v1[0], v1[1]); w.w = pg8::cvt_pk_bf16(v1[2], v1[3]);
                    *(u32x4*)(rowp + bj * 128) = w; } }
    }
};
struct EpiF32 {
    static constexpr bool PERM = false;
    float* O; int ldc; const float* ss; const float* sw;
    __device__ __forceinline__ void operator()(const AccT& acc, const pg8::Unit& u, int wr, int wc, int fr, int fq) const {
        const int row0 = u.pm * 256 + wr * 64 + fr, col0 = u.pn * 256 + wc * 32 + 4 * fq;
        const float* swp = sw + (size_t)cond_of_tile(u.pm) * 6144 + col0;
        f32x4 sv[2][2];
#pragma unroll
        for (int bj = 0; bj < 2; ++bj)
#pragma unroll
            for (int n = 0; n < 2; ++n) sv[bj][n] = *(const f32x4*)(swp + bj * 128 + n * 16);
        float rsd[2][4];
        { f32x4 t[2][4]; const int lane = fq * 16 + fr;
#pragma unroll
            for (int ai = 0; ai < 2; ++ai)
#pragma unroll
                for (int m = 0; m < 4; ++m) t[ai][m] = *(const f32x4*)(ss + (size_t)(row0 + ai * 128 + m * 16) * 16 + 4 * fq);
#pragma unroll
            for (int ai = 0; ai < 2; ++ai)
#pragma unroll
                for (int m = 0; m < 4; ++m) { float q = (t[ai][m][0] + t[ai][m][1]) + (t[ai][m][2] + t[ai][m][3]); q += shfl_xor_l(q, lane, 16); q += shfl_xor_l(q, lane, 32);
                    rsd[ai][m] = rsqrtf(q * (1.f / 1024.f) + 1e-6f); } }
#pragma unroll
        for (int ai = 0; ai < 2; ++ai)
#pragma unroll
            for (int m = 0; m < 4; ++m) { const int row = row0 + ai * 128 + m * 16; float* rowp = O + (size_t)row * ldc + col0;
                const float rstd = rsd[ai][m];
#pragma unroll
                for (int bj = 0; bj < 2; ++bj)
#pragma unroll
                    for (int n = 0; n < 2; ++n) *(f32x4*)(rowp + bj * 128 + n * 16) = acc[ai][bj][m][n] * rstd + sv[bj][n]; }
    }
};
struct EpiResid {
    static constexpr bool PERM = true;
    const float* base0; const float* base1; float* out; const float* gate;
    bf16_t* XG; const float* gn; const float* sc; float* ss;
    __device__ __forceinline__ void operator()(const AccT& acc, const pg8::Unit& u, int wr, int wc, int fr, int fq) const {
        const int row0 = u.pm * 256 + wr * 64 + fr, col0 = u.pn * 256 + wc * 32 + 8 * fq, cnd = cond_of_tile(u.pm), lane = fq * 16 + fr;
        const float* gp = gate + (size_t)cnd * 6144 + col0;
        const float* bp = (u.pm < 16) ? base0 : base1 - (size_t)MCTX * D;
        const bool xg = XG != nullptr;
        f32x4 gv[2][2], gm[2][2]; float sqa[2][4];
#pragma unroll
        for (int bj = 0; bj < 2; ++bj)
#pragma unroll
            for (int n = 0; n < 2; ++n) { gv[bj][n] = *(const f32x4*)(gp + bj * 128 + n * 4);
                if (xg) gm[bj][n] = *(const f32x4*)(gn + col0 + bj * 128 + n * 4) * (*(const f32x4*)(sc + (size_t)cnd * 6144 + col0 + bj * 128 + n * 4) + 1.f);
                else gm[bj][n] = (f32x4){0.f, 0.f, 0.f, 0.f}; }
#pragma unroll
        for (int aim = 0; aim < 4; ++aim) { const int ai = aim >> 1, mb = (aim & 1) * 2;
            f32x4 bb[4][2][2];
#pragma unroll
            for (int m = mb; m < mb + 2; ++m)
#pragma unroll
                for (int bj = 0; bj < 2; ++bj)
#pragma unroll
                    for (int n = 0; n < 2; ++n) bb[m][bj][n] = *(const f32x4*)(bp + (size_t)(row0 + ai * 128 + m * 16) * D + col0 + bj * 128 + n * 4);
#pragma unroll
            for (int m = mb; m < mb + 2; ++m) { const int row = row0 + ai * 128 + m * 16; const size_t off = (size_t)row * D + col0; float sq = 0.f;
#pragma unroll
                for (int bj = 0; bj < 2; ++bj) {
                    const f32x4 x0 = bb[m][bj][0] + gv[bj][0] * acc[ai][bj][m][0], x1 = bb[m][bj][1] + gv[bj][1] * acc[ai][bj][m][1];
                    *(f32x4*)(out + off + bj * 128) = x0; *(f32x4*)(out + off + bj * 128 + 4) = x1;
                    if (xg) { sq += ((x0[0] * x0[0] + x0[1] * x0[1]) + (x0[2] * x0[2] + x0[3] * x0[3])) + ((x1[0] * x1[0] + x1[1] * x1[1]) + (x1[2] * x1[2] + x1[3] * x1[3]));
                        const f32x4 y0 = x0 * gm[bj][0], y1 = x1 * gm[bj][1];
                        *(u32x4*)(XG + off + bj * 128) = (u32x4){pg8::cvt_pk_bf16(y0[0], y0[1]), pg8::cvt_pk_bf16(y0[2], y0[3]), pg8::cvt_pk_bf16(y1[0], y1[1]), pg8::cvt_pk_bf16(y1[2], y1[3])}; } }
                sqa[ai][m] = sq; }
        }
        if (xg) {
#pragma unroll
            for (int ai = 0; ai < 2; ++ai)
#pragma unroll
                for (int m = 0; m < 4; ++m) sqa[ai][m] += shfl_xor_l(sqa[ai][m], lane, 16);
#pragma unroll
            for (int ai = 0; ai < 2; ++ai)
#pragma unroll
                for (int m = 0; m < 4; ++m) sqa[ai][m] += shfl_xor_l(sqa[ai][m], lane, 32);
            if (fq == 0) {
#pragma unroll
                for (int ai = 0; ai < 2; ++ai)
#pragma unroll
                    for (int m = 0; m < 4; ++m) ss[(size_t)(row0 + ai * 128 + m * 16) * 16 + u.pn * 4 + wc] = sqa[ai][m]; }
        }
    }
};
struct EpiGates {
    static constexpr bool PERM = true;
    const bf16_t* XC; unsigned* AB; const float* ba; const float* bx; const float* sp;
    __device__ __forceinline__ void operator()(const AccT& acc, const pg8::Unit& u, int wr, int wc, int fr, int fq) const {
        const int blk = u.pn >> 1, dir = u.pn & 1;
        const int row0 = u.pm * 256 + wr * 64 + fr, ch0 = blk * 128 + wc * 32 + 8 * fq;
        unsigned* ab = AB + (size_t)dir * M * 1024;
        u32x2 xwa[2][2][4];
#pragma unroll
        for (int n = 0; n < 2; ++n)
#pragma unroll
            for (int ai = 0; ai < 2; ++ai)
#pragma unroll
                for (int m = 0; m < 4; ++m) xwa[n][ai][m] = *(const u32x2*)(XC + (size_t)(row0 + ai * 128 + m * 16) * 1024 + ch0 + 4 * n);
#pragma unroll
        for (int n = 0; n < 2; ++n) {
            const f32x4 vba = *(const f32x4*)(ba + dir * 1024 + ch0 + 4 * n), vbx = *(const f32x4*)(bx + dir * 1024 + ch0 + 4 * n), vsp = *(const f32x4*)(sp + dir * 1024 + ch0 + 4 * n);
#pragma unroll
            for (int ai = 0; ai < 2; ++ai)
#pragma unroll
                for (int m = 0; m < 4; ++m) { const size_t off = (size_t)(row0 + ai * 128 + m * 16) * 1024 + ch0 + 4 * n;
                    const u32x2 xw = xwa[n][ai][m];
                    const float xf[4] = {bflo(xw.x), bfhi(xw.x), bflo(xw.y), bfhi(xw.y)};
                    unsigned o[4];
#pragma unroll
                    for (int j = 0; j < 4; ++j) {
                        const float r = sigmoidf_(acc[ai][0][m][n][j] + vba[j]);
                        const float la = -r * vsp[j];
                        const float uu = fmaxf(1.f - __expf(2.f * la), 1e-20f), vv = 1.f + __expf(-(acc[ai][1][m][n][j] + vbx[j]));
                        const float bb = uu * __builtin_amdgcn_rsqf(uu * vv * vv) * xf[j];
                        o[j] = pk2(la, bb); }
                    *(u32x4*)(ab + off) = (u32x4){o[0], o[1], o[2], o[3]};
                    __builtin_amdgcn_sched_barrier(0); }
        }
    }
};
struct EpiQ {
    static constexpr bool PERM = true;
    bf16_t* Q; const float* rope; float qscale;
    __device__ __forceinline__ void operator()(const AccT& acc, const pg8::Unit& u, int wr, int wc, int fr, int fq) const {
        const int row0 = u.pm * 256 + wr * 64 + fr;
#pragma unroll
        for (int bj = 0; bj < 2; ++bj) {
            const int col0 = u.pn * 256 + bj * 128 + wc * 32 + 8 * fq; const int within = col0 % 192;
            const bool pe = (within >= 128) && (u.pm >= 16); const int i0 = pe ? ((within - 128) >> 1) : 0;
            bf16_t* qp = Q + (size_t)row0 * QW + col0;
            const float* rp0 = rope + (size_t)i0 * 2;
#pragma unroll
            for (int ai = 0; ai < 2; ++ai)
#pragma unroll
                for (int m = 0; m < 4; ++m) { const int rr = ai * 128 + m * 16;
                    f32x4 v0 = acc[ai][bj][m][0], v1 = acc[ai][bj][m][1];
                    if (pe) { const int pos = (row0 + rr - MCTX) & 2047; const float* rp = rp0 + (size_t)pos * 64;
                        const f32x4 r0 = *(const f32x4*)rp, r1 = *(const f32x4*)(rp + 4);
                        const f32x4 a = v0, b = v1;
                        v0[0] = a[0] * r0[0] - a[1] * r0[1]; v0[1] = a[0] * r0[1] + a[1] * r0[0];
                        v0[2] = a[2] * r0[2] - a[3] * r0[3]; v0[3] = a[2] * r0[3] + a[3] * r0[2];
                        v1[0] = b[0] * r1[0] - b[1] * r1[1]; v1[1] = b[0] * r1[1] + b[1] * r1[0];
                        v1[2] = b[2] * r1[2] - b[3] * r1[3]; v1[3] = b[2] * r1[3] + b[3] * r1[2]; }
                    v0 = v0 * qscale; v1 = v1 * qscale;
                    u32x4 w; w.x = pg8::cvt_pk_bf16(v0[0], v0[1]); w.y = pg8::cvt_pk_bf16(v0[2], v0[3]); w.z = pg8::cvt_pk_bf16(v1[0], v1[1]); w.w = pg8::cvt_pk_bf16(v1[2], v1[3]);
                    *(u32x4*)(qp + (size_t)rr * QW) = w;
                    __builtin_amdgcn_sched_barrier(0); }
        }
    }
};

__device__ __forceinline__ void rstd_prepass(LAS float* rs, const float* ss, int Mr, int N) {
    pg8::StaticOrder S; S.init(Mr, N, (int)gridDim.x, opaque_bid());
    const int tid = opaque_tid(), lane = tid & 63, rl = tid >> 1, half = tid & 1;
    pg8::Unit u;
    for (int i = 0; S.next(i, u); ++i) {
        const float* sp = ss + (size_t)(u.pm * 256 + rl) * 16 + half * 8;
        const f32x4 a = *(const f32x4*)sp, b = *(const f32x4*)(sp + 4); const f32x4 t4 = a + b;
        float t = (t4[0] + t4[1]) + (t4[2] + t4[3]); t += shfl_xor_l(t, lane, 1);
        if (half == 0) rs[i * 256 + rl] = rsqrtf(t * (1.f / 1024.f) + 1e-6f);
    }
    __syncthreads();
}
template <class Epi>
__device__ __forceinline__ void run_gemm(LAS unsigned char* lds, const bf16_t* A, int lda, const bf16_t* Bt, int ldb, int Mr, int N, int K, int a_sh, int a_colbytes, const Epi& E, int lim = 1 << 30) {
    pg8::Gemm g{A, Bt, lda, ldb, K, a_sh, a_colbytes, 0, nullptr, nullptr};
    pg8::StaticOrder S; S.init(Mr, N, (int)gridDim.x, opaque_bid()); if (lim < S.lim) S.lim = lim;
    pg8::gemm_phase<Epi, pg8::StaticOrder, true, true>(lds, g, S, E);
}
struct EpiDual {
    static constexpr bool PERM = true;
    bf16_t* O0; int ld0; bf16_t* O1; int ld1;
    __device__ __forceinline__ void operator()(const AccT& acc, const pg8::Unit& u, int wr, int wc, int fr, int fq) const {
        bf16_t* base = u.which ? O1 : O0; const int ldc = u.which ? ld1 : ld0;
        const int row0 = u.pm * 256 + wr * 64 + fr, col0 = u.pn * 256 + wc * 32 + 8 * fq;
#pragma unroll
        for (int ai = 0; ai < 2; ++ai)
#pragma unroll
            for (int m = 0; m < 4; ++m) { bf16_t* rowp = base + (size_t)(row0 + ai * 128 + m * 16) * ldc + col0;
#pragma unroll
                for (int bj = 0; bj < 2; ++bj) { const f32x4 v0 = acc[ai][bj][m][0], v1 = acc[ai][bj][m][1];
                    u32x4 w; w.x = pg8::cvt_pk_bf16(v0[0], v0[1]); w.y = pg8::cvt_pk_bf16(v0[2], v0[3]); w.z = pg8::cvt_pk_bf16(v1[0], v1[1]); w.w = pg8::cvt_pk_bf16(v1[2], v1[3]);
                    *(u32x4*)(rowp + bj * 128) = w; } }
    }
};
__device__ __forceinline__ void run_gemm_dual(LAS unsigned char* lds, const bf16_t* A0, const bf16_t* B0, int M0, int N0, const bf16_t* A1, const bf16_t* B1, int M1, int N1, int ld, int K, const EpiDual& E) {
    pg8::Gemm g{A0, B0, ld, ld, K, 0, 0, 0, A1, B1};
    pg8::DualOrder S{M0 / 256, N0 / 256, M1 / 256, N1 / 256, (int)gridDim.x, opaque_bid()};
    pg8::gemm_phase<EpiDual, pg8::DualOrder, true, true>(lds, g, S, E);
}
struct EpiPartial {
    static constexpr bool PERM = false;
    float* part; int base, nM, nN;
    __device__ __forceinline__ void operator()(const AccT& acc, const pg8::Unit& u, int wr, int wc, int fr, int fq) const {
        const int slot = opaque_bid();
        float* O = part + (size_t)slot * 65536;
        const int row0 = wr * 64 + fr, col0 = wc * 32 + 4 * fq;
#pragma unroll
        for (int ai = 0; ai < 2; ++ai)
#pragma unroll
            for (int m = 0; m < 4; ++m) { float* rowp = O + (size_t)(row0 + ai * 128 + m * 16) * 256 + col0;
#pragma unroll
                for (int bj = 0; bj < 2; ++bj)
#pragma unroll
                    for (int n = 0; n < 2; ++n) *(f32x4*)(rowp + bj * 128 + n * 16) = acc[ai][bj][m][n]; }
    }
};
template <class Epi>
__device__ __forceinline__ void run_gemm_split(LAS unsigned char* lds, const bf16_t* A, int lda, const bf16_t* Bt, int ldb, int Mr, int N, int Kq, int base, const Epi& E) {
    pg8::Gemm g{A, Bt, lda, ldb, Kq, 0, 0, Kq * 2, nullptr, nullptr};
    pg8::SplitOrder S{Mr / 256, N / 256, base, opaque_bid()};
    pg8::gemm_phase<Epi, pg8::SplitOrder, true, true>(lds, g, S, E);
}
__device__ __forceinline__ void split_reduce_phase(const float* part, float* X, const float* gate, int base, int nM, int nN, bf16_t* XG, const float* gn, const float* sc, float* ss) {
    const int tid_ = opaque_tid(), lane = tid_ & 63; const int gt = opaque_bid() * 512 + tid_, NT = gridDim.x * 512;
    const int nsplit = nM * nN - base, nit = nsplit * 16384;
    for (int it0 = gt; it0 < nit; it0 += 4 * NT) {
        f32x4 p[4][4], xo[4], gv[4], gm[4]; int rowv[4], colv[4], pnv[4]; bool ok[4];
#pragma unroll
        for (int i = 0; i < 4; ++i) { const int it = it0 + i * NT; ok[i] = it < nit;
            const int itc = ok[i] ? it : it0;
            const int su = itc >> 14, e = itc & 16383, r = e >> 6, c4 = (e & 63) * 4;
            pg8::Unit u; pg8::unit_of(base + su, nM, nN, u);
            const float* pp = part + (size_t)su * 4 * 65536 + r * 256 + c4;
#pragma unroll
            for (int k4 = 0; k4 < 4; ++k4) p[i][k4] = *(const f32x4*)(pp + (size_t)k4 * 65536);
            rowv[i] = u.pm * 256 + r; colv[i] = u.pn * 256 + c4; pnv[i] = u.pn; const int cnd = cond_of_tile(u.pm);
            xo[i] = *(const f32x4*)(X + (size_t)rowv[i] * D + colv[i]);
            gv[i] = *(const f32x4*)(gate + (size_t)cnd * 6144 + colv[i]);
            if (XG != nullptr) gm[i] = *(const f32x4*)(gn + colv[i]) * (*(const f32x4*)(sc + (size_t)cnd * 6144 + colv[i]) + 1.f); else gm[i] = (f32x4){0.f, 0.f, 0.f, 0.f}; }
        float sq[4];
#pragma unroll
        for (int i = 0; i < 4; ++i) { const f32x4 s4 = (p[i][0] + p[i][1]) + (p[i][2] + p[i][3]); const f32x4 xn = xo[i] + gv[i] * s4;
            if (ok[i]) *(f32x4*)(X + (size_t)rowv[i] * D + colv[i]) = xn;
            sq[i] = (xn[0] * xn[0] + xn[1] * xn[1]) + (xn[2] * xn[2] + xn[3] * xn[3]);
            if (XG != nullptr && ok[i]) { const f32x4 y = xn * gm[i]; *(u32x2*)(XG + (size_t)rowv[i] * D + colv[i]) = (u32x2){pk2(y[0], y[1]), pk2(y[2], y[3])}; } }
        if (XG != nullptr) {
#pragma unroll
            for (int o_ = 1; o_ < 64; o_ <<= 1) {
#pragma unroll
                for (int i = 0; i < 4; ++i) sq[i] += shfl_xor_l(sq[i], lane, o_); }
#pragma unroll
            for (int i = 0; i < 4; ++i) if (ok[i] && lane < 4) ss[(size_t)rowv[i] * 16 + pnv[i] * 4 + lane] = lane == 0 ? sq[i] : 0.f;
        }
    }
}
__device__ __forceinline__ void sw_phase(const float* mod, const unsigned char* ws, float* sW) {
    const int tid_ = opaque_tid(), lane = tid_ & 63, gw = opaque_bid() * 8 + (tid_ >> 6), NGW = gridDim.x * 8;
    const int r16 = lane & 15, q = lane >> 4;
    for (int it = gw; it < 1408; it += NGW) {
        int l = 0, n0 = 0; bool up = false;
        { int r = it;
          for (int ll = 0; ll < 4; ++ll) { const int nmix = (ll & 1) ? 64 : 128;
              if (r < nmix) { l = ll; n0 = r * 16; up = false; break; } r -= nmix;
              if (r < 256) { l = ll; n0 = r * 16; up = true; break; } r -= 256; } }
        const int j = l >> 1;
        const bf16_t* wt;
        if (up) wt = (const bf16_t*)(ws + WS_W1T) + ((size_t)l * 4096 + n0) * 1024;
        else if (l & 1) wt = (const bf16_t*)(ws + WS_WDQT) + ((size_t)j * 1024 + n0) * 1024;
        else wt = (const bf16_t*)(ws + WS_WINT) + ((size_t)j * 2048 + n0) * 1024;
        const bf16_t* wp = wt + (size_t)r16 * 1024 + 8 * q;
        const bool cv = r16 < 9;
        const float* shp = mod + ((size_t)l * 9 + (cv ? r16 : 0)) * 6144 + (up ? 3 : 0) * 1024 + 8 * q;
        f32x4 acc = (f32x4){0.f, 0.f, 0.f, 0.f};
#pragma unroll 1
        for (int kb = 0; kb < 4; ++kb) {
            bf16x8 bfr[8]; f32x4 a0[8], a1[8];
#pragma unroll
            for (int s8 = 0; s8 < 8; ++s8) { const int k0 = kb * 256 + s8 * 32;
                bfr[s8] = *(const bf16x8*)(wp + k0); a0[s8] = *(const f32x4*)(shp + k0); a1[s8] = *(const f32x4*)(shp + k0 + 4); }
#pragma unroll
            for (int s8 = 0; s8 < 8; ++s8) { u32x4 aw;
                aw.x = pk2(a0[s8][0], a0[s8][1]); aw.y = pk2(a0[s8][2], a0[s8][3]); aw.z = pk2(a1[s8][0], a1[s8][1]); aw.w = pk2(a1[s8][2], a1[s8][3]);
                if (!cv) aw = (u32x4){0u, 0u, 0u, 0u};
                acc = __builtin_amdgcn_mfma_f32_16x16x32_bf16(__builtin_bit_cast(bf16x8, aw), bfr[s8], acc, 0, 0, 0); }
        }
#pragma unroll
        for (int i = 0; i < 4; ++i) { const int cnd = 4 * q + i; if (cnd < 9) sW[((size_t)l * 9 + cnd) * 6144 + (up ? 2048 : 0) + n0 + r16] = acc[i]; }
    }
}

struct Params { const float* in[29]; float* out; unsigned char* ws; int ph_lo, ph_hi; };
enum { I_XP = 0, I_XS, I_STATE, I_CCKV, I_CKPE, I_C, I_CCTX, I_ADAW, I_ADAB, I_NMIX, I_NMLP, I_W1, I_W2, I_WIN, I_CONVW, I_CONVB, I_WA, I_BA, I_WX, I_BX, I_LAM, I_WOUT,
       I_WDQ, I_NQ, I_NKV, I_WUQ, I_WUKV, I_WO, I_FN };

__device__ __forceinline__ void transpose_item(const float* src, int ldsrc, int k0, int n0, bf16_t* dstrow0, int lddst, LAS float* scr, int lane) {
#pragma unroll 8
    for (int i = 0; i < 32; ++i) { const int kk = 2 * i + (lane >> 5); scr[kk * 33 + (lane & 31)] = src[(size_t)(k0 + kk) * ldsrc + n0 + (lane & 31)]; }
    asm volatile("s_waitcnt lgkmcnt(0)" ::: "memory");
    const int c = lane & 7;
#pragma unroll
    for (int j = 0; j < 4; ++j) { const int n = (lane >> 3) + 8 * j; const LAS float* s = scr + (8 * c) * 33 + n;
        u32x4 o; o.x = pk2(s[0 * 33], s[1 * 33]); o.y = pk2(s[2 * 33], s[3 * 33]); o.z = pk2(s[4 * 33], s[5 * 33]); o.w = pk2(s[6 * 33], s[7 * 33]);
        *(u32x4*)(dstrow0 + (size_t)n * lddst + k0 + 8 * c) = o; }
    asm volatile("s_waitcnt lgkmcnt(0)" ::: "memory");
}

__device__ __forceinline__ void phase0(KArgP pk, LAS unsigned char* lds) {
    const int tid = opaque_tid(), lane = tid & 63, wave = tid >> 6, bid = opaque_bid();
    const int G = gridDim.x, gw = bid * 8 + wave, NGW = G * 8;
    unsigned char* ws = pk->ws;
    {
        const int gt = bid * 512 + tid, NT = G * 512;
        float2* rope = (float2*)(ws + WS_ROPE);
        for (int e = gt; e < 2048 * 32; e += NT) { const int pos = e >> 5, i = e & 31;
            const float inv = exp2f(-(float)(i & 15) * 0.83048202372f);
            const float ang = (float)(i < 16 ? (pos >> 6) : (pos & 63)) * inv;
            float rev = ang * 0.15915494309f; rev -= floorf(rev);
            rope[e] = make_float2(__builtin_amdgcn_cosf(rev), __builtin_amdgcn_sinf(rev)); }
        float* sp = (float*)(ws + WS_SP);
        for (int e = gt; e < 2 * 2 * 1024; e += NT) sp[e] = 8.f * log1pf(__expf(-pk->in[I_LAM][e]));
        for (int e = gt; e < 2 * 192 * 128; e += NT) { const int j = e / (192 * 128), r = e % (192 * 128);
            ((u32x4*)(ws + WS_WDQT + (size_t)j * 2 * MiB + (size_t)832 * 1024 * 2))[r] = (u32x4){0u, 0u, 0u, 0u}; }
    }
    {
        LAS float* scr = (LAS float*)(lds + wave * 16384);
        constexpr int IT_W1 = 16 * 128, IT_W2 = 64 * 32, IT_WIN = 16 * 64, IT_SQ = 16 * 32, IT_G = 8, IT_DQ = 16 * 26, IT_UQ = 8 * 48, IT_UKV = 4 * 64;
        constexpr int N1 = 4 * IT_W1, N2 = 4 * IT_W2, N3 = 2 * IT_WIN, N4 = 2 * IT_SQ, N5 = 64 * IT_G, N6 = 2 * IT_DQ, N7 = 2 * IT_UQ, N8 = 2 * IT_UKV, N9 = 2 * IT_SQ;
        constexpr int NITEMS = N1 + N2 + N3 + N4 + N5 + N6 + N7 + N8 + N9;
        for (int it = gw; it < NITEMS; it += NGW) {
            int r = it;
            if (r < N1) { const int l = r / IT_W1, q = r % IT_W1, kb = q / 128, nb = q % 128;
                transpose_item(pk->in[I_W1] + (size_t)l * 1024 * 4096, 4096, kb * 64, nb * 32, (bf16_t*)(ws + WS_W1T) + ((size_t)l * 4096 + nb * 32) * 1024, 1024, scr, lane); continue; } r -= N1;
            if (r < N2) { const int l = r / IT_W2, q = r % IT_W2, kb = q / 32, nb = q % 32;
                transpose_item(pk->in[I_W2] + (size_t)l * 4096 * 1024, 1024, kb * 64, nb * 32, (bf16_t*)(ws + WS_W2T) + ((size_t)l * 1024 + nb * 32) * 4096, 4096, scr, lane); continue; } r -= N2;
            if (r < N3) { const int j = r / IT_WIN, q = r % IT_WIN, kb = q / 64, nb = q % 64;
                transpose_item(pk->in[I_WIN] + (size_t)j * 1024 * 2048, 2048, kb * 64, nb * 32, (bf16_t*)(ws + WS_WINT) + ((size_t)j * 2048 + nb * 32) * 1024, 1024, scr, lane); continue; } r -= N3;
            if (r < N4) { const int j = r / IT_SQ, q = r % IT_SQ, kb = q / 32, nb = q % 32;
                transpose_item(pk->in[I_WOUT] + (size_t)j * 1024 * 1024, 1024, kb * 64, nb * 32, (bf16_t*)(ws + WS_WOUTT) + ((size_t)j * 1024 + nb * 32) * 1024, 1024, scr, lane); continue; } r -= N4;
            if (r < N5) { const int mat = r / IT_G, q = r % IT_G, kb = q / 4, nb = q % 4;
                const int which = mat & 1, blk = (mat >> 1) & 7, dir = (mat >> 4) & 1, j = mat >> 5;
                const float* src = (which ? pk->in[I_WX] : pk->in[I_WA]) + (size_t)(((j * 2 + dir) * 8 + blk)) * 128 * 128;
                bf16_t* dst = (bf16_t*)(ws + WS_WGT) + ((size_t)j * 4096 + (blk * 2 + dir) * 256 + which * 128 + nb * 32) * 128;
                transpose_item(src, 128, kb * 64, nb * 32, dst, 128, scr, lane); continue; } r -= N5;
            if (r < N6) { const int j = r / IT_DQ, q = r % IT_DQ, kb = q / 26, nb = q % 26;
                transpose_item(pk->in[I_WDQ] + (size_t)j * 1024 * 832, 832, kb * 64, nb * 32, (bf16_t*)(ws + WS_WDQT) + ((size_t)j * 1024 + nb * 32) * 1024, 1024, scr, lane); continue; } r -= N6;
            if (r < N7) { const int j = r / IT_UQ, q = r % IT_UQ, kb = q / 48, nb = q % 48;
                transpose_item(pk->in[I_WUQ] + (size_t)j * 512 * 1536, 1536, kb * 64, nb * 32, (bf16_t*)(ws + WS_WUQT) + ((size_t)j * 1536 + nb * 32) * 512, 512, scr, lane); continue; } r -= N7;
            if (r < N8) { const int j = r / IT_UKV, q = r % IT_UKV, kb = q / 64, nb = q % 64;
                const int n0 = nb * 32, head = n0 >> 8, within = n0 & 255;
                bf16_t* dst = within < 128 ? (bf16_t*)(ws + WS_WUKT) + ((size_t)j * 1024 + head * 128 + within) * 256
                                           : (bf16_t*)(ws + WS_WUVT) + ((size_t)j * 1024 + head * 128 + within - 128) * 256;
                transpose_item(pk->in[I_WUKV] + (size_t)j * 256 * 2048, 2048, kb * 64, n0, dst, 256, scr, lane); continue; } r -= N8;
            { const int j = r / IT_SQ, q = r % IT_SQ, kb = q / 32, nb = q % 32;
                transpose_item(pk->in[I_WO] + (size_t)j * 1024 * 1024, 1024, kb * 64, nb * 32, (bf16_t*)(ws + WS_WOT) + ((size_t)j * 1024 + nb * 32) * 1024, 1024, scr, lane); }
        }
    }
    __syncthreads();
    {
        LAS float* sl = (LAS float*)lds;
        LAS float* red = (LAS float*)(lds + 36864);
        for (int e = tid; e < 9 * 1024; e += 512) { const int cnd = e >> 10, k = e & 1023;
            const float v = cnd == 0 ? pk->in[I_CCTX][k] : pk->in[I_C][(cnd - 1) * 1024 + k]; sl[e] = v / (1.f + __expf(-v)); }
        __syncthreads();
        float* mod = (float*)(ws + WS_MOD);
        const int half = lane >> 5, l32 = lane & 31;
        for (int unit = bid; unit < 4 * 48; unit += G) {
            const int l = unit / 48, cb = unit % 48, col = cb * 128 + l32 * 4;
            const float* w = pk->in[I_ADAW] + (size_t)l * 1024 * 6144 + col;
            f32x4 acc[9];
#pragma unroll
            for (int c = 0; c < 9; ++c) acc[c] = (f32x4){0.f, 0.f, 0.f, 0.f};
            const int kbase = wave * 128 + half;
#pragma unroll 4
            for (int i = 0; i < 64; ++i) { const int k = kbase + 2 * i; const f32x4 wv = *(const f32x4*)(w + (size_t)k * 6144);
#pragma unroll
                for (int c = 0; c < 9; ++c) acc[c] += wv * sl[c * 1024 + k]; }
            const int part = wave * 2 + half;
#pragma unroll
            for (int c = 0; c < 9; ++c)
#pragma unroll
                for (int j = 0; j < 4; ++j) red[(part * 36 + c * 4 + j) * 32 + l32] = acc[c][j];
            __syncthreads();
            for (int o = tid; o < 9 * 128; o += 512) { const int c = o >> 7, cc = o & 127, ll = cc >> 2, j = cc & 3; float s = 0.f;
#pragma unroll
                for (int pp = 0; pp < 16; ++pp) s += red[(pp * 36 + c * 4 + j) * 32 + ll];
                mod[((size_t)l * 9 + c) * 6144 + cb * 128 + cc] = s + pk->in[I_ADAB][l * 6144 + cb * 128 + cc]; }
            __syncthreads();
        }
    }
}

__device__ __forceinline__ void norm_phase(const float* x0, const float* x1, const float* gn, const float* modl, int iscale, bf16_t* H, float* ss) {
    const int tid_ = opaque_tid(), lane = tid_ & 63, gw = opaque_bid() * 8 + (tid_ >> 6), NGW = gridDim.x * 8;
    f32x4 nv[4];
    if (gw < M) { const float* xr = gw < MCTX ? x0 + (size_t)gw * D : x1 + (size_t)(gw - MCTX) * D;
#pragma unroll
        for (int j = 0; j < 4; ++j) nv[j] = *(const f32x4*)(xr + 4 * lane + 256 * j); }
    for (int row = gw; row < M; row += NGW) {
        const int cnd = row < MCTX ? 0 : 1 + ((row - MCTX) >> 11);
        const float* sc = modl + (size_t)cnd * 6144 + iscale * 1024;
        f32x4 v[4]; float sq = 0.f;
#pragma unroll
        for (int j = 0; j < 4; ++j) v[j] = nv[j];
        const int rn = row + NGW;
        if (rn < M) { const float* xr = rn < MCTX ? x0 + (size_t)rn * D : x1 + (size_t)(rn - MCTX) * D;
#pragma unroll
            for (int j = 0; j < 4; ++j) nv[j] = *(const f32x4*)(xr + 4 * lane + 256 * j); }
#pragma unroll
        for (int j = 0; j < 4; ++j) sq += (v[j][0] * v[j][0] + v[j][1] * v[j][1]) + (v[j][2] * v[j][2] + v[j][3] * v[j][3]);
        sq = wave_sum(sq, lane);
        if (lane < 16) ss[(size_t)row * 16 + lane] = lane == 0 ? sq : 0.f;
#pragma unroll
        for (int j = 0; j < 4; ++j) { const int c = 4 * lane + 256 * j;
            const f32x4 g = *(const f32x4*)(gn + c), s_ = *(const f32x4*)(sc + c);
            const f32x4 y = v[j] * g * (s_ + 1.f);
            *(u32x2*)(H + (size_t)row * D + c) = (u32x2){pk2(y[0], y[1]), pk2(y[2], y[3])}; }
    }
}
__device__ __forceinline__ void final_norm_phase(float* X, const float* gn) {
    const int tid_ = opaque_tid(), lane = tid_ & 63, gw = opaque_bid() * 8 + (tid_ >> 6), NGW = gridDim.x * 8;
    f32x4 g[4];
#pragma unroll
    for (int j = 0; j < 4; ++j) g[j] = *(const f32x4*)(gn + 4 * lane + 256 * j);
    f32x4 nv[4];
    if (gw < M) {
#pragma unroll
        for (int j = 0; j < 4; ++j) nv[j] = *(const f32x4*)(X + (size_t)gw * D + 4 * lane + 256 * j); }
    for (int row = gw; row < M; row += NGW) {
        float* xr = X + (size_t)row * D;
        f32x4 v[4]; float ss = 0.f;
#pragma unroll
        for (int j = 0; j < 4; ++j) v[j] = nv[j];
        if (row + NGW < M) {
#pragma unroll
            for (int j = 0; j < 4; ++j) nv[j] = *(const f32x4*)(xr + (size_t)NGW * D + 4 * lane + 256 * j); }
#pragma unroll
        for (int j = 0; j < 4; ++j) ss += (v[j][0] * v[j][0] + v[j][1] * v[j][1]) + (v[j][2] * v[j][2] + v[j][3] * v[j][3]);
        const float rstd = rsqrtf(wave_sum(ss, lane) * (1.f / D) + 1e-6f);
#pragma unroll
        for (int j = 0; j < 4; ++j) *(f32x4*)(xr + 4 * lane + 256 * j) = v[j] * rstd * g[j];
    }
}
__device__ __forceinline__ void conv_phase(const bf16_t* XB, bf16_t* XC, const float* cw, const float* cb) {
    const int gt = opaque_bid() * 512 + opaque_tid(), NT = gridDim.x * 512;
    for (int it = gt; it < (M / 8) * 128; it += NT) {
        const int tg = it >> 7, cgp = it & 127, ch0 = cgp * 8, r0 = tg * 8;
        const int seqlen = r0 < MCTX ? 256 : 2048; const int t0 = r0 < MCTX ? (r0 & 255) : ((r0 - MCTX) & 2047);
        float w[4][8], bias[8];
#pragma unroll
        for (int k = 0; k < 4; ++k)
#pragma unroll
            for (int j = 0; j < 8; ++j) w[k][j] = cw[k * 1024 + ch0 + j];
#pragma unroll
        for (int j = 0; j < 8; ++j) bias[j] = cb[ch0 + j];
        float acc[8][8];
#pragma unroll
        for (int t = 0; t < 8; ++t)
#pragma unroll
            for (int j = 0; j < 8; ++j) acc[t][j] = bias[j];
#pragma unroll
        for (int s = 0; s < 11; ++s) {
            const int ts = t0 - 1 + s;
            u32x4 xw = (u32x4){0u, 0u, 0u, 0u};
            if (ts >= 0 && ts < seqlen) xw = *(const u32x4*)(XB + (size_t)(r0 - 1 + s) * 1024 + ch0);
            const float xf[8] = {bflo(xw.x), bfhi(xw.x), bflo(xw.y), bfhi(xw.y), bflo(xw.z), bfhi(xw.z), bflo(xw.w), bfhi(xw.w)};
#pragma unroll
            for (int k = 0; k < 4; ++k) { const int t = s - k;
                if (t >= 0 && t < 8) {
#pragma unroll
                    for (int j = 0; j < 8; ++j) acc[t][j] += w[k][j] * xf[j]; } }
        }
#pragma unroll
        for (int t = 0; t < 8; ++t)
            *(u32x4*)(XC + (size_t)(r0 + t) * 1024 + ch0) = (u32x4){pk2(acc[t][0], acc[t][1]), pk2(acc[t][2], acc[t][3]), pk2(acc[t][4], acc[t][5]), pk2(acc[t][6], acc[t][7])};
    }
}
__device__ __forceinline__ void scan1_phase(const unsigned* AB, float* car) {
    const int gt = opaque_bid() * 512 + opaque_tid(), NT = gridDim.x * 512;
    for (int it = gt; it < 2 * 640 * 256; it += NT) {
        const int cg4 = it & 255, c = (it >> 8) % 640, dir = it / (640 * 256);
        const unsigned* ab = AB + ((size_t)dir * M + c * 32) * 1024 + cg4 * 4;
        u32x4 v[32];
#pragma unroll
        for (int s = 0; s < 32; ++s) v[s] = *(const u32x4*)(ab + (size_t)s * 1024);
        asm volatile("" ::: "memory");
        float sl[4] = {0.f, 0.f, 0.f, 0.f}, h[4] = {0.f, 0.f, 0.f, 0.f};
        if (dir == 0) {
#pragma unroll
            for (int s = 0; s < 32; ++s) { const unsigned vv[4] = {v[s].x, v[s].y, v[s].z, v[s].w};
#pragma unroll
                for (int j = 0; j < 4; ++j) { const float la = bflo(vv[j]), b = bfhi(vv[j]); h[j] = __expf(la) * h[j] + b; sl[j] += la; } }
        } else {
#pragma unroll
            for (int s = 31; s >= 0; --s) { const unsigned vv[4] = {v[s].x, v[s].y, v[s].z, v[s].w};
#pragma unroll
                for (int j = 0; j < 4; ++j) { const float la = bflo(vv[j]), b = bfhi(vv[j]); h[j] = __expf(la) * h[j] + b; sl[j] += la; } }
        }
        float* o = car + (((size_t)dir * 640 + c) * 1024 + cg4 * 4) * 2;
        *(f32x4*)o = (f32x4){sl[0], h[0], sl[1], h[1]}; *(f32x4*)(o + 4) = (f32x4){sl[2], h[2], sl[3], h[3]};
    }
}
__device__ __forceinline__ void scan2_phase(float* car, const float* state_in  , int j, float* out_state) {
    const int gt = opaque_bid() * 512 + opaque_tid(), NT = gridDim.x * 512;
    for (int it = gt; it < 2 * 24 * 1024; it += NT) {
        const int ch = it & 1023, seq = (it >> 10) % 24, dir = it / (24 * 1024);
        const int c0 = seq < 16 ? seq * 8 : 128 + (seq - 16) * 64, nc = seq < 16 ? 8 : 64;
        float h = seq < 16 ? 0.f : state_in[(((size_t)(seq - 16) * 2 + j) * 2 + dir) * 1024 + ch];
        float2* cp = (float2*)car + ((size_t)dir * 640 + c0) * 1024 + ch;
#pragma unroll 8
        for (int s = 0; s < nc; ++s) { const int c = dir ? nc - 1 - s : s; const float2 v = cp[(size_t)c * 1024];
            cp[(size_t)c * 1024].y = h; h = __expf(v.x) * h + v.y; }
        if (seq < 16) out_state[(((size_t)seq * 2 + j) * 2 + dir) * 1024 + ch] = h;
    }
}
__device__ __forceinline__ void scan3_phase(const unsigned* AB, const float* car, const bf16_t* YB, bf16_t* Gout) {
    const int gt = opaque_bid() * 512 + opaque_tid(), NT = gridDim.x * 512;
    for (int it = gt; it < 640 * 512; it += NT) {
        const int cp = it & 511, c = it >> 9, ch = cp * 2;
        const size_t rb = (size_t)c * 32 * 1024 + ch;
        u32x2 vf[32], vb[32]; unsigned yv[32];
        const f32x4 cif = *(const f32x4*)(car + (((size_t)0 * 640 + c) * 1024 + ch) * 2), cib = *(const f32x4*)(car + (((size_t)1 * 640 + c) * 1024 + ch) * 2);
#pragma unroll
        for (int t = 0; t < 32; ++t) vf[t] = *(const u32x2*)(AB + rb + (size_t)t * 1024);
#pragma unroll
        for (int t = 0; t < 32; ++t) vb[t] = *(const u32x2*)(AB + (size_t)M * 1024 + rb + (size_t)t * 1024);
#pragma unroll
        for (int t = 0; t < 32; ++t) yv[t] = *(const unsigned*)(YB + rb + (size_t)t * 1024);
        asm volatile("" ::: "memory");
        float hf[32][2];
        { float h0 = cif[1], h1 = cif[3];
#pragma unroll
          for (int t = 0; t < 32; ++t) { h0 = __expf(bflo(vf[t].x)) * h0 + bfhi(vf[t].x); h1 = __expf(bflo(vf[t].y)) * h1 + bfhi(vf[t].y); hf[t][0] = h0; hf[t][1] = h1; } }
        { float h0 = cib[1], h1 = cib[3];
#pragma unroll
          for (int t = 31; t >= 0; --t) { h0 = __expf(bflo(vb[t].x)) * h0 + bfhi(vb[t].x); h1 = __expf(bflo(vb[t].y)) * h1 + bfhi(vb[t].y);
              *(unsigned*)(Gout + rb + (size_t)t * 1024) = pk2((hf[t][0] + h0) * bflo(yv[t]), (hf[t][1] + h1) * bfhi(yv[t])); } }
    }
}
__device__ __forceinline__ int kvrow_of(int row) { return row < MCTX ? row : MCTX + ((row - MCTX) >> 11) * KVB + ((row - MCTX) & 2047); }
__device__ __forceinline__ void mla_post_phase(const float* PROJ, const float* gq, const float* gkv, const float* rope, const float* cckv, const float* ckpe, int j,
                                               bf16_t* CQ, bf16_t* CKV, bf16_t* KPE, float* out_ckv, float* out_kpe) {
    const int tid_ = opaque_tid(), lane = tid_ & 63, gw = opaque_bid() * 8 + (tid_ >> 6), NGW = gridDim.x * 8;
    const f32x4 ga = *(const f32x4*)(gq + 4 * lane), gb = *(const f32x4*)(gq + 256 + 4 * lane), gk = *(const f32x4*)(gkv + 4 * lane);
#define MP_LOAD(r, A_, B_, C_, K_) do { if ((r) < M) { const float* pr_ = PROJ + (size_t)(r) * 1024; A_ = *(const f32x4*)(pr_ + 4 * lane); B_ = *(const f32x4*)(pr_ + 256 + 4 * lane); C_ = *(const f32x4*)(pr_ + 512 + 4 * lane); \
            K_ = *(const f32x2*)(pr_ + 768 + 2 * (lane & 31)); } \
        else { const int cr_ = (r) - M, bb_ = cr_ >> 8, s_ = cr_ & 255; A_ = (f32x4){0.f, 0.f, 0.f, 0.f}; B_ = A_; C_ = *(const f32x4*)(cckv + (((size_t)bb_ * 2 + j) * 256 + s_) * 256 + 4 * lane); \
            K_ = *(const f32x2*)(ckpe + (((size_t)bb_ * 2 + j) * 256 + s_) * 64 + 2 * (lane & 31)); } } while (0)
    f32x4 na, nb, nc; f32x2 nk;
    if (gw < M + 2048) MP_LOAD(gw, na, nb, nc, nk);
    for (int row = gw; row < M + 2048; row += NGW) {
        const f32x4 a = na, b = nb, cv = nc; const f32x2 kp = nk;
        if (row + NGW < M + 2048) MP_LOAD(row + NGW, na, nb, nc, nk);
        if (row < M) {
            const float ssq = wave_sum((a[0] * a[0] + a[1] * a[1]) + (a[2] * a[2] + a[3] * a[3]) + (b[0] * b[0] + b[1] * b[1]) + (b[2] * b[2] + b[3] * b[3]), lane);
            const float ssk = wave_sum((cv[0] * cv[0] + cv[1] * cv[1]) + (cv[2] * cv[2] + cv[3] * cv[3]), lane);
            const float rq = rsqrtf(ssq * (1.f / 512.f) + 1e-6f), rk = rsqrtf(ssk * (1.f / 256.f) + 1e-6f);
            const f32x4 ya = a * rq * ga, yb = b * rq * gb, yk = cv * rk * gk;
            *(u32x2*)(CQ + (size_t)row * 512 + 4 * lane) = (u32x2){pk2(ya[0], ya[1]), pk2(ya[2], ya[3])};
            *(u32x2*)(CQ + (size_t)row * 512 + 256 + 4 * lane) = (u32x2){pk2(yb[0], yb[1]), pk2(yb[2], yb[3])};
            const int kr = kvrow_of(row);
            *(u32x2*)(CKV + (size_t)kr * 256 + 4 * lane) = (u32x2){pk2(yk[0], yk[1]), pk2(yk[2], yk[3])};
            if (row < MCTX) { const int bb = row >> 8, t = row & 255; *(f32x4*)(out_ckv + (((size_t)bb * 2 + j) * 256 + t) * 256 + 4 * lane) = yk; }
            if (lane < 32) { float x1 = kp[0], x2 = kp[1];
                if (row < MCTX) { const int bb = row >> 8, t = row & 255; *(f32x2*)(out_kpe + (((size_t)bb * 2 + j) * 256 + t) * 64 + 2 * lane) = kp; }
                else { const int pos = (row - MCTX) & 2047; const f32x2 cs = *(const f32x2*)(rope + ((size_t)pos * 32 + lane) * 2);
                    const float o1 = x1 * cs[0] - x2 * cs[1], o2 = x1 * cs[1] + x2 * cs[0]; x1 = o1; x2 = o2; }
                *(unsigned*)(KPE + (size_t)kr * 64 + 2 * lane) = pk2(x1, x2); }
        } else {
            const int cr = row - M, bb = cr >> 8, s = cr & 255, kr = MCTX + bb * KVB + 2048 + s;
            *(u32x2*)(CKV + (size_t)kr * 256 + 4 * lane) = (u32x2){pk2(cv[0], cv[1]), pk2(cv[2], cv[3])};
            if (lane < 32) *(unsigned*)(KPE + (size_t)kr * 64 + 2 * lane) = pk2(kp[0], kp[1]);
        }
    }
#undef MP_LOAD
}

constexpr int AT_PE = 16384, AT_VT = 24576, ATT_BUF = 40960;
__device__ __forceinline__ void attn_phase(LAS unsigned char* lds, const bf16_t* Q, const bf16_t* KN, const bf16_t* KPE, const bf16_t* VT, bf16_t* O) {
    const int tid = opaque_tid(), lane = tid & 63, wave = __builtin_amdgcn_readfirstlane(tid >> 6), q32 = lane & 31, hi = lane >> 5;
    const int G = gridDim.x, bx = opaque_bid();
    const int xcd = bx & 7, idx = bx >> 3;
    const int pi_row = 16 * ((q32 >> 3) >> 1) + 8 * ((q32 >> 2) & 1) + 4 * ((q32 >> 3) & 1) + (q32 & 3);
    const unsigned laneN = (unsigned)(pi_row * 256 + (((pi_row & 15) ^ hi) * 16));
    const unsigned laneP = (unsigned)(AT_PE + pi_row * 128 + ((((pi_row >> 1) & 7) ^ hi) * 16));
    const unsigned laneV = (unsigned)(AT_VT + q32 * 128 + ((((q32 >> 1) & 7) ^ hi) * 16));
    const int rN = 8 * wave + (lane >> 4), cN = (lane & 15) ^ (rN & 15);
    const unsigned oN0 = (unsigned)(rN * 1024 + cN * 8) * 2u, oN1 = (unsigned)((rN + 4) * 1024 + (cN ^ 4) * 8) * 2u;
    const int rP = 8 * wave + (lane >> 3), cP = (lane & 7) ^ ((rP >> 1) & 7);
    const unsigned oP = (unsigned)(rP * 64 + cP * 8) * 2u;
    const int dV = 16 * wave + (lane >> 3), cV = (lane & 7) ^ ((dV >> 1) & 7);
    const unsigned oV0 = (unsigned)(dV * MKV + cV * 8) * 2u, oV1 = (unsigned)((dV + 8) * MKV + (cV ^ 4) * 8) * 2u;
    for (int ui = bx; ui < 512 + 128; ui += G) {
        int qrow0, kv0, ntile, h;
        if (ui < 512) {
            int bh, qb;
            if (G == 256) { const int r = ui >> 8; bh = r * 32 + xcd * 4 + (idx >> 3); qb = idx & 7; } else { bh = ui >> 3; qb = ui & 7; }
            const int b = bh >> 3; h = bh & 7; qrow0 = MCTX + b * 2048 + qb * 256; kv0 = MCTX + b * KVB; ntile = 36;
        } else { const int v = ui - 512, b = v >> 3; h = v & 7; qrow0 = b * 256; kv0 = b * 256; ntile = 4; }
        bf16x8 qf[12];
        { const char* qb_ = (const char*)(Q + (size_t)(qrow0 + wave * 32) * QW + h * 192); const unsigned qo_ = (unsigned)(q32 * QW + 8 * hi) * 2u;
#pragma unroll
          for (int ks = 0; ks < 12; ++ks) qf[ks] = *(const bf16x8*)(qb_ + 32 * ks + qo_); }
        f32x16 oacc[4];
#pragma unroll
        for (int d = 0; d < 4; ++d)
#pragma unroll
            for (int r = 0; r < 16; ++r) oacc[d][r] = 0.f;
        float m_run = -1e30f, l_run = 0.f;
        const char* bKn = (const char*)(KN + (size_t)kv0 * 1024 + h * 128);
        const char* bKp = (const char*)(KPE + (size_t)kv0 * 64);
        const char* bV = (const char*)(VT + (size_t)(h * 128) * MKV + kv0);
#define ATT_GLDS(g, l) __builtin_amdgcn_global_load_lds((const unsigned*)(g), (LAS unsigned*)(l), 16, 0, 0)
#define ATT_DMA(t, bufb) do { const char* k_ = bKn + (size_t)(t) * (64 * 1024 * 2); const char* p_ = bKp + (size_t)(t) * (64 * 64 * 2); const char* v_ = bV + (size_t)(t) * 128; \
        LAS unsigned char* d_ = lds + (bufb); \
        ATT_GLDS(k_ + oN0, d_ + (2 * wave) * 1024); ATT_GLDS(k_ + oN1, d_ + (2 * wave + 1) * 1024); ATT_GLDS(p_ + oP, d_ + AT_PE + wave * 1024); \
        ATT_GLDS(v_ + oV0, d_ + AT_VT + (2 * wave) * 1024); ATT_GLDS(v_ + oV1, d_ + AT_VT + (2 * wave + 1) * 1024); } while (0)
        asm volatile("s_waitcnt lgkmcnt(0)" ::: "memory"); __builtin_amdgcn_s_barrier(); asm volatile("" ::: "memory");
        ATT_DMA(0, 0); ATT_DMA(1, ATT_BUF);
        int bcur = 0;
        for (int t = 0; t < ntile; ++t) {
            if (t + 1 < ntile) asm volatile("s_waitcnt vmcnt(5)" ::: "memory"); else asm volatile("s_waitcnt vmcnt(0)" ::: "memory");
            asm volatile("s_waitcnt lgkmcnt(0)" ::: "memory"); __builtin_amdgcn_s_barrier(); asm volatile("" ::: "memory");
            const int bprev = bcur == 0 ? 2 * ATT_BUF : bcur - ATT_BUF;
            if (t + 2 < ntile) ATT_DMA(t + 2, bprev);
            const unsigned aN = laneN + (unsigned)bcur, aP = laneP + (unsigned)bcur, aV = laneV + (unsigned)bcur;
            bcur = bcur == 2 * ATT_BUF ? 0 : bcur + ATT_BUF;
            f32x16 s0, s1;
#pragma unroll
            for (int r = 0; r < 16; ++r) { s0[r] = 0.f; s1[r] = 0.f; }
#pragma unroll
            for (int ks = 0; ks < 12; ++ks) {
                const unsigned pa = ks < 8 ? (aN ^ (unsigned)(ks * 32)) : (aP ^ (unsigned)((ks - 8) * 32));
                const bf16x8 a0 = *(const LAS bf16x8*)(lds + pa), a1 = *(const LAS bf16x8*)(lds + pa + (ks < 8 ? 8192 : 4096));
                s0 = __builtin_amdgcn_mfma_f32_32x32x16_bf16(a0, qf[ks], s0, 0, 0, 0);
                s1 = __builtin_amdgcn_mfma_f32_32x32x16_bf16(a1, qf[ks], s1, 0, 0, 0);
            }
            float mx = s0[0];
#pragma unroll
            for (int r = 1; r < 16; ++r) mx = fmaxf(mx, s0[r]);
#pragma unroll
            for (int r = 0; r < 16; ++r) mx = fmaxf(mx, s1[r]);
            mx = fmaxf(mx, shfl_xor_l(mx, lane, 32));
            const float m_new = fmaxf(m_run, mx), alpha = __builtin_amdgcn_exp2f(m_run - m_new);
            const bool grow = __builtin_amdgcn_ballot_w64(m_new > m_run) != 0ull; m_run = m_new;
            float ls = 0.f;
#pragma unroll
            for (int r = 0; r < 16; ++r) { s0[r] = __builtin_amdgcn_exp2f(s0[r] - m_new); s1[r] = __builtin_amdgcn_exp2f(s1[r] - m_new); ls += s0[r] + s1[r]; }
            l_run = l_run * alpha + ls;
            if (grow) {
#pragma unroll
                for (int d = 0; d < 4; ++d)
#pragma unroll
                    for (int r = 0; r < 16; ++r) oacc[d][r] *= alpha;
            }
            bf16x8 pb[2][2];
#pragma unroll
            for (int jj = 0; jj < 2; ++jj) {
                u32x4 w0, w1;
                w0.x = pg8::cvt_pk_bf16(s0[8 * jj + 0], s0[8 * jj + 1]); w0.y = pg8::cvt_pk_bf16(s0[8 * jj + 2], s0[8 * jj + 3]);
                w0.z = pg8::cvt_pk_bf16(s0[8 * jj + 4], s0[8 * jj + 5]); w0.w = pg8::cvt_pk_bf16(s0[8 * jj + 6], s0[8 * jj + 7]);
                w1.x = pg8::cvt_pk_bf16(s1[8 * jj + 0], s1[8 * jj + 1]); w1.y = pg8::cvt_pk_bf16(s1[8 * jj + 2], s1[8 * jj + 3]);
                w1.z = pg8::cvt_pk_bf16(s1[8 * jj + 4], s1[8 * jj + 5]); w1.w = pg8::cvt_pk_bf16(s1[8 * jj + 6], s1[8 * jj + 7]);
                pb[0][jj] = __builtin_bit_cast(bf16x8, w0); pb[1][jj] = __builtin_bit_cast(bf16x8, w1);
            }
#pragma unroll
            for (int hf = 0; hf < 2; ++hf)
#pragma unroll
                for (int jj = 0; jj < 2; ++jj) {
                    const unsigned pv = aV ^ (unsigned)(hf * 64 + jj * 32);
#pragma unroll
                    for (int d = 0; d < 4; ++d) {
                        const bf16x8 av = *(const LAS bf16x8*)(lds + pv + d * 4096);
                        oacc[d] = __builtin_amdgcn_mfma_f32_32x32x16_bf16(av, pb[hf][jj], oacc[d], 0, 0, 0);
                    }
                }
        }
        const float lt = l_run + shfl_xor_l(l_run, lane, 32), inv = 1.f / lt;
        char* ob_ = (char*)(O + (size_t)(qrow0 + wave * 32) * 1024 + h * 128); const unsigned oo_ = (unsigned)(q32 * 1024 + 4 * hi) * 2u;
#pragma unroll
        for (int d = 0; d < 4; ++d)
#pragma unroll
            for (int g4 = 0; g4 < 4; ++g4)
                *(u32x2*)(ob_ + (d * 32 + g4 * 8) * 2 + oo_) = (u32x2){pk2(oacc[d][4 * g4 + 0] * inv, oacc[d][4 * g4 + 1] * inv), pk2(oacc[d][4 * g4 + 2] * inv, oacc[d][4 * g4 + 3] * inv)};
#undef ATT_GLDS
#undef ATT_DMA
    }
    asm volatile("s_waitcnt vmcnt(0) lgkmcnt(0)" ::: "memory"); __builtin_amdgcn_s_barrier(); asm volatile("" ::: "memory");
}

#define XB_TMO      128
#define XB_XCNT(j)  (256  + 64 * (j))
#define XB_XSUB(j)  (1280 + 64 * (j))
#define XB_XGEN(j)  (2304 + 64 * (j))
#define XB_TOP      3328
#define XB_TOPGEN   3392
#define XCD_BAR_WORDS 3456
#define XB_SPIN_CAP (1u << 22)
__device__ __forceinline__ unsigned xb_ld(unsigned* p)              { return __hip_atomic_load(p, __ATOMIC_RELAXED, __HIP_MEMORY_SCOPE_AGENT); }
__device__ __forceinline__ unsigned xb_add(unsigned* p, unsigned v) { return __hip_atomic_fetch_add(p, v, __ATOMIC_RELAXED, __HIP_MEMORY_SCOPE_AGENT); }
__device__ __forceinline__ unsigned xb_xcc_id() { return (unsigned)__builtin_amdgcn_s_getreg((3 << 11) | 20) & 0xFu; }
#define XB_SPIN(cond, bar) do { unsigned _sp = 0; while (cond) { __builtin_amdgcn_s_sleep(1); \
    if ((++_sp & 255u) == 0u) { if (xb_ld(&(bar)[XB_TMO])) break; if (_sp > XB_SPIN_CAP) { atomicAdd(&(bar)[XB_TMO], 1u); break; } } } } while (0)
struct XcdBarrier { unsigned* bar; unsigned x; volatile LAS unsigned* st; };
__device__ __forceinline__ XcdBarrier xcd_barrier_post(unsigned* bar, volatile LAS unsigned* st) {
    XcdBarrier b; b.bar = bar; b.x = xb_xcc_id(); b.st = st;
    if (threadIdx.x == 0) (void)xb_add(&bar[XB_XCNT(b.x)], 1u);
    return b;
}
__device__ __forceinline__ void xcd_barrier_complete(unsigned* bar, unsigned x, unsigned& nloc, unsigned& nx) {
    const unsigned G = gridDim.x * gridDim.y * gridDim.z;
    unsigned sum, cnt, mine, sp = 0u;
    for (;;) {
        sum = 0u; cnt = 0u; mine = 0u;
#pragma unroll
        for (unsigned j = 0; j < 16; ++j) { const unsigned c = xb_ld(&bar[XB_XCNT(j)]); sum += c; cnt += (c > 0u) ? 1u : 0u; mine = (j == x) ? c : mine; }
        if (sum == G) break;
        __builtin_amdgcn_s_sleep(1);
        if ((++sp & 255u) == 0u) { if (xb_ld(&bar[XB_TMO])) break; if (sp > XB_SPIN_CAP) { atomicAdd(&bar[XB_TMO], 1u); break; } }
    }
    nloc = mine > 0u ? mine : 1u; nx = cnt > 0u ? cnt : 1u;
}
__device__ __forceinline__ void xcd_barrier(const XcdBarrier& b) {
    asm volatile("s_waitcnt vmcnt(0)" ::: "memory");
    __syncthreads();
    if (threadIdx.x == 0) {
        unsigned* bar = b.bar;
        __builtin_amdgcn_s_waitcnt(0);
        unsigned nloc = b.st[0], nx = b.st[1];
        if (nloc == 0u) { xcd_barrier_complete(bar, b.x, nloc, nx); b.st[0] = nloc; b.st[1] = nx; }
        const unsigned old = xb_add(&bar[XB_XSUB(b.x)], 1u);
        const unsigned gen = old / nloc;
        if (old + 1u == (gen + 1u) * nloc) {
            __builtin_amdgcn_fence(__ATOMIC_RELEASE, "agent");
            asm volatile("s_waitcnt vmcnt(0)" ::: "memory");
            const unsigned og = xb_add(&bar[XB_TOP], 1u);
            const unsigned tg = og / nx;
            if (og + 1u == (tg + 1u) * nx) xb_add(&bar[XB_TOPGEN], 1u);
            else XB_SPIN(xb_ld(&bar[XB_TOPGEN]) == tg, bar);
            __builtin_amdgcn_fence(__ATOMIC_ACQUIRE, "agent");
            xb_add(&bar[XB_XGEN(b.x)], 1u);
            asm volatile("s_waitcnt vmcnt(0)" ::: "memory");
        } else {
            XB_SPIN(xb_ld(&bar[XB_XGEN(b.x)]) == gen, bar);
            __builtin_amdgcn_fence(__ATOMIC_ACQUIRE, "agent");
            asm volatile("s_waitcnt vmcnt(0)" ::: "memory");
        }
    }
    __syncthreads();
}

constexpr int N_PHASES = 39;
__global__ void __launch_bounds__(512, 2) fwd_kernel(Params p) {
    extern __shared__ __attribute__((aligned(16))) unsigned char lds_raw[];
    LAS unsigned char* lds = (LAS unsigned char*)lds_raw;
    cg::grid_group grid = cg::this_grid();
    const int lo = p.ph_lo, hi = p.ph_hi;
    int k = 0, l = 0;
    if (threadIdx.x < 16) ((LAS unsigned*)(lds + 131072))[threadIdx.x] = 0u;
    __syncthreads();
    XcdBarrier xbar = xcd_barrier_post((unsigned*)(p.ws + WS_BAR), (volatile LAS unsigned*)(lds + 131072));
#ifndef EN_MASK
#define EN_MASK 0xFFFFFFFFu
#endif
#define PH_BEGIN(id) if (((EN_MASK >> (id)) & 1u) && k >= lo && k < hi) { KArgP q = opaque_kernarg(); unsigned char* ws = q->ws; float* X = q->out; \
        const int j = l >> 1; const float* modl = (const float*)(ws + WS_MOD) + (size_t)l * 9 * 6144; const float* rope = (const float*)(ws + WS_ROPE); bf16_t* H = (bf16_t*)(ws + WS_H); \
        const float* xb0 = l == 0 ? q->in[I_XP] : X; const float* xb1 = l == 0 ? q->in[I_XS] : X + (size_t)MCTX * D; \
        bf16_t* XB = (bf16_t*)(ws + S_XB); bf16_t* YB = (bf16_t*)(ws + S_YB); bf16_t* XC = (bf16_t*)(ws + S_XC); unsigned* AB = (unsigned*)(ws + S_AB); float* car = (float*)(ws + S_CAR); \
        float* PROJ = (float*)(ws + S_PROJ); bf16_t* CQ = (bf16_t*)(ws + S_CQ); bf16_t* CKV = (bf16_t*)(ws + S_CKV); bf16_t* KPE = (bf16_t*)(ws + S_KPE); \
        bf16_t* Qb = (bf16_t*)(ws + S_Q); bf16_t* KN = (bf16_t*)(ws + S_KN); bf16_t* VT = (bf16_t*)(ws + S_VT); bf16_t* A2 = (bf16_t*)(ws + S_A2); \
        float* SS = (float*)(ws + WS_SS); const float* SWl = (const float*)(ws + WS_SW) + (size_t)l * 9 * 6144; bf16_t* OB = (bf16_t*)(ws + S_O); LAS float* RS = (LAS float*)(lds + 131072); (void)SS; (void)SWl; (void)OB; (void)RS; \
        (void)j; (void)modl; (void)rope; (void)H; (void)xb0; (void)xb1; (void)XB; (void)YB; (void)XC; (void)AB; (void)car; (void)PROJ; (void)CQ; (void)CKV; (void)KPE; (void)Qb; (void)KN; (void)VT; (void)A2; (void)X;
#define PH_END   if (k + 1 < hi) { if (hi < 0) grid.sync();   xcd_barrier(xbar); } } ++k;

    PH_BEGIN(0) phase0(q, lds); PH_END

    for (l = 0; l < 4; ++l) {
        if (l == 0) { PH_BEGIN(1) norm_phase(xb0, xb1, q->in[I_NMIX], modl, 1, H, SS); sw_phase((const float*)(ws + WS_MOD), ws, (float*)(ws + WS_SW)); PH_END }
        if ((l & 1) == 0) {
            PH_BEGIN(2) { EpiBf16<2, true> E{XB, YB, 1024, SS, SWl}; run_gemm(lds, H, 1024, (const bf16_t*)(ws + WS_WINT) + (size_t)j * 2048 * 1024, 1024, M, 2048, 1024, 0, 0, E); } PH_END
            PH_BEGIN(3) conv_phase(XB, XC, q->in[I_CONVW] + j * 4096, q->in[I_CONVB] + j * 1024); PH_END
            PH_BEGIN(4) { EpiGates E{XC, AB, q->in[I_BA] + j * 2048, q->in[I_BX] + j * 2048, (const float*)(ws + WS_SP) + j * 2048};
                       run_gemm(lds, XC, 1024, (const bf16_t*)(ws + WS_WGT) + (size_t)j * 4096 * 128, 128, M, 4096, 128, 1, 256, E); } PH_END
            PH_BEGIN(5) scan1_phase(AB, car); PH_END
            PH_BEGIN(6) scan2_phase(car, q->in[I_STATE], j, X + OUT_STATE); PH_END
            PH_BEGIN(7) scan3_phase(AB, car, YB, YB); PH_END
            PH_BEGIN(8) { EpiResid E{xb0, xb1, X, modl + 2 * 1024, H, q->in[I_NMLP] + l * 1024, modl + 4 * 1024, SS};
                       run_gemm(lds, YB, 1024, (const bf16_t*)(ws + WS_WOUTT) + (size_t)j * 1024 * 1024, 1024, M, 1024, 1024, 0, 0, E); } PH_END
        } else {
            PH_BEGIN(9) { EpiF32 E{PROJ, 1024, SS, SWl}; run_gemm(lds, H, 1024, (const bf16_t*)(ws + WS_WDQT) + (size_t)j * 1024 * 1024, 1024, M, 1024, 1024, 0, 0, E); } PH_END
            PH_BEGIN(10) mla_post_phase(PROJ, q->in[I_NQ] + j * 512, q->in[I_NKV] + j * 256, rope, q->in[I_CCKV], q->in[I_CKPE], j, CQ, CKV, KPE, X + OUT_CKV, X + OUT_KPE); PH_END
            PH_BEGIN(11) { EpiQ EQ{Qb, rope, 0.07216878364870322f * 1.4426950408889634f};
                       run_gemm(lds, CQ, 512, (const bf16_t*)(ws + WS_WUQT) + (size_t)j * 1536 * 512, 512, M, 1536, 512, 0, 0, EQ);
                       EpiDual EKV{KN, 1024, VT, MKV};
                       run_gemm_dual(lds, CKV, (const bf16_t*)(ws + WS_WUKT) + (size_t)j * 1024 * 256, MKV, 1024,
                                     (const bf16_t*)(ws + WS_WUVT) + (size_t)j * 1024 * 256, CKV, 1024, MKV, 256, 256, EKV); } PH_END
            PH_BEGIN(12) attn_phase(lds, Qb, KN, KPE, VT, OB); PH_END
            PH_BEGIN(13) { EpiResid E{xb0, xb1, X, modl + 2 * 1024, H, q->in[I_NMLP] + l * 1024, modl + 4 * 1024, SS};
                       run_gemm(lds, OB, 1024, (const bf16_t*)(ws + WS_WOT) + (size_t)j * 1024 * 1024, 1024, M, 1024, 1024, 0, 0, E); } PH_END
        }
        PH_BEGIN(15) { EpiBf16<1, true> E{A2, nullptr, 4096, SS, SWl + 2048}; run_gemm(lds, H, 1024, (const bf16_t*)(ws + WS_W1T) + (size_t)l * 4096 * 1024, 1024, M, 4096, 1024, 0, 0, E); } PH_END
        PH_BEGIN(16) { const int G_ = (int)gridDim.x; const bool split = (G_ == 256);
                       EpiResid E{X, X + (size_t)MCTX * D, X, modl + 5 * 1024, l < 3 ? H : nullptr, q->in[I_NMIX] + (l + 1) * 1024, modl + 9 * 6144 + 1024, SS};
                       const bf16_t* W2 = (const bf16_t*)(ws + WS_W2T) + (size_t)l * 1024 * 4096;
                       run_gemm(lds, A2, 4096, W2, 4096, M, 1024, 4096, 0, 0, E, split ? 256 : (1 << 30));
                       if (split) { EpiPartial EP{(float*)(ws + S_PART), 256, 80, 4}; run_gemm_split(lds, A2, 4096, W2, 4096, M, 1024, 1024, 256, EP); } } PH_END
        PH_BEGIN(17) { if ((int)gridDim.x == 256) split_reduce_phase((const float*)(ws + S_PART), X, modl + 5 * 1024, 256, 80, 4, l < 3 ? H : nullptr, q->in[I_NMIX] + (l + 1) * 1024, modl + 9 * 6144 + 1024, SS); } PH_END
    }
    PH_BEGIN(18) final_norm_phase(X, q->in[I_FN]); PH_END
#undef PH_BEGIN
#undef PH_END
}

#ifndef MULTI_LAUNCH
#define MULTI_LAUNCH 0
#endif
extern "C" void kernel_launch(void* const* d_in, const int* in_sizes, int n_in, void* d_out, int out_size, void* d_ws, size_t ws_size, hipStream_t stream) {
    static int grid = 0;
    if (grid == 0) {
        int dev = 0, cus = 0, per_cu = 0;
        hipGetDevice(&dev);
        hipDeviceGetAttribute(&cus, hipDeviceAttributeMultiprocessorCount, dev);
        hipFuncSetAttribute((const void*)fwd_kernel, hipFuncAttributeMaxDynamicSharedMemorySize, LDS_BYTES);
        hipOccupancyMaxActiveBlocksPerMultiprocessor(&per_cu, (const void*)fwd_kernel, 512, LDS_BYTES);
        if (per_cu < 1) per_cu = 1;
        grid = cus * 1;
        if (ws_size < WS_END || n_in != 29) { fprintf(stderr, "kernel_launch: ws_size %zu < %zu or n_in %d != 29\n", ws_size, (size_t)WS_END, n_in); }
        (void)hipGetLastError();
    }
    (void)hipMemsetAsync((char*)d_ws + WS_BAR, 0, BAR_BYTES, stream);
    Params p{};
    for (int i = 0; i < 29; ++i) p.in[i] = (const float*)d_in[i];
    p.out = (float*)d_out; p.ws = (unsigned char*)d_ws;
#if MULTI_LAUNCH
    for (int k = 0; k < N_PHASES; ++k) { p.ph_lo = k; p.ph_hi = k + 1; hipLaunchKernelGGL(fwd_kernel, dim3(grid), dim3(512), LDS_BYTES, stream, p); }
#else
    p.ph_lo = 0; p.ph_hi = N_PHASES;
    void* args[] = {&p};
    hipError_t e = hipLaunchCooperativeKernel((const void*)fwd_kernel, dim3(grid), dim3(512), args, LDS_BYTES, stream);
    if (e != hipSuccess) fprintf(stderr, "cooperative launch failed: %s (grid %d)\n", hipGetErrorString(e), grid);
#endif
}
```

```cpp
#include <hip/hip_runtime.h>
#include <hip/hip_cooperative_groups.h>
#include <cstdio>
#include <cstdint>
namespace cg = cooperative_groups;

#define LAS __attribute__((address_space(3)))
typedef unsigned short bf16_t;
typedef short bf16x8 __attribute__((ext_vector_type(8)));
typedef float f32x4 __attribute__((ext_vector_type(4)));
typedef float f32x2 __attribute__((ext_vector_type(2)));
typedef float f32x16 __attribute__((ext_vector_type(16)));
typedef unsigned u32x4 __attribute__((ext_vector_type(4)));
typedef unsigned u32x2 __attribute__((ext_vector_type(2)));

constexpr int D = 1024, MCTX = 4096, M = 20480, FF = 4096, MKV = 22528, KVB = 2304;
constexpr int QW = 1536;
constexpr size_t MiB = 1u << 20;
constexpr size_t WS_MOD = 0, WS_ROPE = 1 * MiB, WS_SP = 1 * MiB + 512 * 1024, WS_BAR = 1 * MiB + 768 * 1024, BAR_BYTES = 16384;
constexpr size_t WS_W1T = 2 * MiB, WS_W2T = 34 * MiB, WS_WINT = 66 * MiB, WS_WGT = 74 * MiB, WS_WOUTT = 76 * MiB, WS_WDQT = 80 * MiB,
                 WS_WUQT = 84 * MiB, WS_WUKT = 87 * MiB, WS_WUVT = 88 * MiB, WS_WOT = 89 * MiB;
constexpr size_t WS_SW = 93 * MiB, WS_SS = 94 * MiB, WS_H = 96 * MiB, WS_S = 136 * MiB, WS_END = 384 * MiB;
constexpr size_t S_A2 = WS_S, S_PART = WS_S + 160 * MiB;
constexpr size_t S_YB = WS_S, S_XC = WS_S + 40 * MiB, S_AB = WS_S + 80 * MiB, S_XB = S_AB, S_CAR = S_XC, S_G = S_YB;
constexpr size_t S_PROJ = WS_S, S_CQ = WS_S + 80 * MiB, S_CKV = WS_S + 100 * MiB, S_KPE = WS_S + 111 * MiB, S_Q = WS_S + 114 * MiB,
                 S_KN = WS_S + 174 * MiB, S_VT = WS_S, S_O = WS_S + 44 * MiB;
static_assert(S_KN + (size_t)MKV * 1024 * 2 <= WS_END && S_AB + 160 * MiB <= WS_END && S_O + 40 * MiB <= S_CKV && S_VT + 44 * MiB <= S_O, "ws map");
constexpr size_t OUT_STATE = (size_t)M * D, OUT_CKV = OUT_STATE + 65536, OUT_KPE = OUT_CKV + 2097152;

constexpr int LDS_BYTES = 147456;

__device__ __forceinline__ unsigned f2bf(float f) { unsigned u = __builtin_bit_cast(unsigned, f); return (u + 0x7fffu + ((u >> 16) & 1u)) >> 16; }
__device__ __forceinline__ unsigned pk2(float lo, float hi) { unsigned r; asm volatile("v_cvt_pk_bf16_f32 %0, %1, %2" : "=v"(r) : "v"(lo), "v"(hi)); return r; }
__device__ __forceinline__ float bflo(unsigned u) { return __builtin_bit_cast(float, u << 16); }
__device__ __forceinline__ float bfhi(unsigned u) { return __builtin_bit_cast(float, u & 0xffff0000u); }
__device__ __forceinline__ float shfl_xor_l(float v, int lane, int o) { return __builtin_bit_cast(float, __builtin_amdgcn_ds_bpermute((lane ^ o) << 2, __builtin_bit_cast(int, v))); }
__device__ __forceinline__ float wave_sum(float v, int lane) {
#pragma unroll
    for (int o = 1; o < 64; o <<= 1) v += shfl_xor_l(v, lane, o);
    return v;
}
struct Params;
typedef const __attribute__((address_space(4))) Params* KArgP;
__device__ __forceinline__ KArgP opaque_kernarg() { auto q = __builtin_amdgcn_kernarg_segment_ptr(); asm volatile("" : "+s"(q)); return (KArgP)q; }
__device__ __forceinline__ int opaque_tid() { int t = threadIdx.x; asm volatile("" : "+v"(t)); return t; }
__device__ __forceinline__ int opaque_bid() { int b = blockIdx.x; asm volatile("" : "+s"(b)); return b; }
__device__ __forceinline__ float sigmoidf_(float x) { return __builtin_amdgcn_rcpf(1.f + __expf(-x)); }
__device__ __forceinline__ int cond_of_tile(int pm) { return pm < 16 ? 0 : 1 + ((pm - 16) >> 3); }

namespace pg8 {
constexpr int BM = 256, BK = 64, HALF = 128, HTB = HALF * BK * 2, STAGE_BYTES = 8 * HTB, NXCD = 8, WGM = 8;
__host__ __device__ __forceinline__ int lds_byte(int r, int c) { const int st = (r >> 4) * 2 + (c >> 5), rr = r & 15, cc = c & 31, ob = rr * 64 + cc * 2; return st * 1024 + (ob ^ (((ob >> 9) & 1) << 5)); }
__host__ __device__ __forceinline__ void stage_rc(int b, int& R, int& C) { const int st = b / 1024, sb = b % 1024, swz = sb ^ (((sb >> 9) & 1) << 5); R = (st >> 1) * 16 + swz / 64; C = (st & 1) * 32 + (swz % 64) / 2; }
__host__ __device__ __forceinline__ int perm32(int rho) { const int n = rho >> 4, i = rho & 15; return 8 * (i >> 2) + 4 * n + (i & 3); }

struct Unit { int pm, pn, kq, idx, which; };
struct Gemm { const bf16_t* A; const bf16_t* Bt; int lda, ldb, K, a_sh, a_colbytes, kq_bytes; const bf16_t* A2; const bf16_t* Bt2; };

__device__ __forceinline__ void unit_of(int wgid, int nM, int nN, Unit& u) {
    const int nwg = nM * nN;
    { const int q = nwg / NXCD, r = nwg % NXCD, xcd = wgid % NXCD, off = wgid / NXCD; wgid = (xcd < r ? xcd * (q + 1) : r * (q + 1) + (xcd - r) * q) + off; }
    const int nig = WGM * nN, gid = wgid / nig, fm = gid * WGM, gsz = (nM - fm) < WGM ? (nM - fm) : WGM;
    u.pm = fm + ((wgid % nig) % gsz); u.pn = (wgid % nig) / gsz; u.kq = 0; u.which = 0;
}
struct StaticOrder {
    int nM, nN, lim, G, c;
    __device__ void init(int M_, int N_, int G_, int c_) { nM = M_ / BM; nN = N_ / BM; lim = nM * nN; G = G_; c = c_; }
    __device__ bool next(int i, Unit& u) const {
        const long L = (long)i * G + c; if (L >= lim) return false;
        unit_of((int)L, nM, nN, u); u.idx = i; return true;
    }
};
struct DualOrder {
    int nM0, nN0, nM1, nN1, G, c;
    __device__ bool next(int i, Unit& u) const {
        const long L = (long)i * G + c; const int n1 = nM0 * nN0;
        if (L >= n1 + nM1 * nN1) return false;
        if (L < n1) unit_of((int)L, nM0, nN0, u); else { unit_of((int)L - n1, nM1, nN1, u); u.which = 1; }
        u.idx = i; return true;
    }
};
struct SplitOrder {
    int nM, nN, base, c;
    __device__ bool next(int i, Unit& u) const {
        if (i > 0) return false; const int L = base + (c >> 2); if (L >= nM * nN) return false;
        unit_of(L, nM, nN, u); u.kq = c & 3; u.idx = 0; return true;
    }
};

__device__ __forceinline__ unsigned cvt_pk_bf16(float lo, float hi) { unsigned r; asm volatile("v_cvt_pk_bf16_f32 %0, %1, %2" : "=v"(r) : "v"(lo), "v"(hi)); return r; }

template <class Epi, class Sched, bool ALIGN_EPI = false, bool SP2 = false>
__device__ __forceinline__ void gemm_phase(LAS unsigned char* lds, const Gemm g, const Sched& S, const Epi& E) {
    const int tid = opaque_tid(), wid = __builtin_amdgcn_readfirstlane(tid >> 6), lane = tid & 63, wr = wid >> 2, wc = wid & 3, fr = lane & 15, fq = lane >> 4;
    int K_ = g.K; asm volatile("" : "+s"(K_)); const int K = K_, nt = K / BK;
    unsigned voffA[2], voffB[2];
#pragma unroll
    for (int i = 0; i < 2; ++i) { int R, C; stage_rc(tid * 16 + i * 8192, R, C); const int Rb = Epi::PERM ? ((R & ~31) + perm32(R & 31)) : R;
        voffA[i] = (unsigned)(R * g.lda + C) * 2u; voffB[i] = (unsigned)(Rb * g.ldb + C) * 2u; }
    const size_t kstep = (size_t)(BK * 2);
    const size_t hA = (size_t)HALF * g.lda * 2, hB = (size_t)HALF * g.ldb * 2;
    const size_t tA = 2 * hA, tB = 2 * hB;
    const unsigned ldsw = (unsigned)wid * 1024u;
    const int aoff = lds_byte(wr * 64 + fr, fq * 8), boff = lds_byte(wc * 32 + fr, fq * 8);
#define PG8_SA(b, h) (((b) * 2 + (h)) * HTB)
#define PG8_SB(b, h) ((4 + (b) * 2 + (h)) * HTB)
#define PG8_STAGE(bufoff, gbase, voff) do { const char* _gb = (const char*)(gbase); asm volatile("" : "+s"(_gb)); _Pragma("unroll") for (int _i = 0; _i < 2; ++_i) \
        __builtin_amdgcn_global_load_lds((const unsigned*)(_gb + (voff)[_i]), (LAS unsigned*)(lds + (bufoff) + ldsw + _i * 8192), 16, 0, 0); } while (0)
#define PG8_LDA(dst, b, h) do { _Pragma("unroll") for (int m = 0; m < 4; ++m) _Pragma("unroll") for (int k = 0; k < 2; ++k) dst[m][k] = *(const LAS bf16x8*)(lds + PG8_SA(b, h) + aoff + m * 2048 + k * 1024); } while (0)
#define PG8_LDB(dst, b, h) do { _Pragma("unroll") for (int n = 0; n < 2; ++n) _Pragma("unroll") for (int k = 0; k < 2; ++k) dst[n][k] = *(const LAS bf16x8*)(lds + PG8_SB(b, h) + boff + n * 2048 + k * 1024); } while (0)
#define PG8_MMA(ai, bj, At, Bt) do { __builtin_amdgcn_s_setprio(1); _Pragma("unroll") for (int m = 0; m < 4; ++m) _Pragma("unroll") for (int n = 0; n < 2; ++n) _Pragma("unroll") for (int k = 0; k < 2; ++k) \
        acc[ai][bj][m][n] = __builtin_amdgcn_mfma_f32_16x16x32_bf16(Bt[n][k], At[m][k], acc[ai][bj][m][n], 0, 0, 0); __builtin_amdgcn_s_setprio(0); } while (0)
#define PG8_WAIT_V(n) asm volatile("s_waitcnt vmcnt(" #n ")" ::: "memory")
#define PG8_WAIT_L(n) asm volatile("s_waitcnt lgkmcnt(" #n ")" ::: "memory")
#define PG8_BAR __builtin_amdgcn_s_barrier()
#define PG8_SCHED __builtin_amdgcn_sched_barrier(0)
#define PG8_OFFA(u) ((size_t)(u).pm * tA + (size_t)((u).pn >> g.a_sh) * (size_t)g.a_colbytes + (size_t)(u).kq * (size_t)g.kq_bytes)
#define PG8_OFFB(u) ((size_t)(u).pn * tB + (size_t)(u).kq * (size_t)g.kq_bytes)
    Unit cur, nxt; int ui = 0;
    if (!S.next(0, cur)) return;
    f32x4 acc[2][2][4][2];
#pragma unroll
    for (int a = 0; a < 2; ++a)
#pragma unroll
        for (int b = 0; b < 2; ++b)
#pragma unroll
            for (int m = 0; m < 4; ++m)
#pragma unroll
                for (int n = 0; n < 2; ++n) acc[a][b][m][n] = (f32x4){0.f, 0.f, 0.f, 0.f};
    bf16x8 At[4][2], B0[2][2], B1[2][2];
    const char* cA = (const char*)(cur.which ? g.A2 : g.A) + PG8_OFFA(cur); const char* cB = (const char*)(cur.which ? g.Bt2 : g.Bt) + PG8_OFFB(cur);
    if constexpr (SP2) {
        PG8_STAGE(PG8_SB(0, 0), cB, voffB); PG8_STAGE(PG8_SB(0, 1), cB + hB, voffB); PG8_STAGE(PG8_SA(0, 0), cA, voffA); PG8_STAGE(PG8_SA(0, 1), cA + hA, voffA);
        if (wr == 1) PG8_BAR;
        PG8_WAIT_V(2); PG8_BAR;
        PG8_STAGE(PG8_SB(1, 0), cB + kstep, voffB); PG8_STAGE(PG8_SA(1, 0), cA + kstep, voffA); PG8_STAGE(PG8_SB(1, 1), cB + hB + kstep, voffB);
        PG8_WAIT_V(6); PG8_BAR;
    } else {
        PG8_STAGE(PG8_SB(0, 0), cB, voffB); PG8_STAGE(PG8_SA(0, 0), cA, voffA); PG8_STAGE(PG8_SB(0, 1), cB + hB, voffB); PG8_STAGE(PG8_SA(0, 1), cA + hA, voffA);
        if (wr == 1) PG8_BAR;
        PG8_WAIT_V(4); PG8_BAR;
        PG8_STAGE(PG8_SB(1, 0), cB + kstep, voffB); PG8_STAGE(PG8_SA(1, 0), cA + kstep, voffA); PG8_STAGE(PG8_SB(1, 1), cB + hB + kstep, voffB);
        PG8_WAIT_V(6); PG8_BAR;
    }
    for (;;) {
        const bool has_next = S.next(ui + 1, nxt);
        const char* nA = has_next ? (const char*)(nxt.which ? g.A2 : g.A) + PG8_OFFA(nxt) : cA; const char* nB = has_next ? (const char*)(nxt.which ? g.Bt2 : g.Bt) + PG8_OFFB(nxt) : cB;
        for (int t = 0; t < nt; t += 2) {
            const bool last = (t == nt - 2);
            const char* a1 = cA + (size_t)(t + 1) * kstep;
            const char* a2 = last ? nA : cA + (size_t)(t + 2) * kstep; const char* b2 = last ? nB : cB + (size_t)(t + 2) * kstep;
            const char* a3 = a2 + kstep; const char* b3 = b2 + kstep;
            if constexpr (SP2) {
            PG8_LDB(B0, 0, 0); PG8_LDB(B1, 0, 1); PG8_SCHED; PG8_LDA(At, 0, 0); PG8_STAGE(PG8_SA(1, 1), a1 + hA, voffA);
            PG8_WAIT_V(8); PG8_WAIT_L(0); PG8_BAR; PG8_MMA(0, 0, At, B0); PG8_MMA(0, 1, At, B1); PG8_BAR; PG8_SCHED;
            PG8_LDA(At, 0, 1); PG8_STAGE(PG8_SB(0, 0), b2, voffB); PG8_STAGE(PG8_SB(0, 1), b2 + hB, voffB); PG8_STAGE(PG8_SA(0, 0), a2, voffA);
            PG8_WAIT_V(8); PG8_WAIT_L(0); PG8_BAR; PG8_MMA(1, 0, At, B0); PG8_MMA(1, 1, At, B1); PG8_BAR; PG8_SCHED;
            PG8_LDB(B0, 1, 0); PG8_LDB(B1, 1, 1); PG8_SCHED; PG8_LDA(At, 1, 0); PG8_STAGE(PG8_SA(0, 1), a2 + hA, voffA);
            PG8_WAIT_V(8); PG8_WAIT_L(0); PG8_BAR; PG8_MMA(0, 0, At, B0); PG8_MMA(0, 1, At, B1); PG8_BAR; PG8_SCHED;
            PG8_LDA(At, 1, 1); PG8_STAGE(PG8_SB(1, 0), b3, voffB); PG8_STAGE(PG8_SB(1, 1), b3 + hB, voffB); PG8_STAGE(PG8_SA(1, 0), a3, voffA);
            PG8_WAIT_V(8); PG8_WAIT_L(0); PG8_BAR; PG8_MMA(1, 0, At, B0); PG8_MMA(1, 1, At, B1); PG8_BAR; PG8_SCHED;
            } else {
            PG8_LDB(B0, 0, 0); PG8_SCHED; PG8_LDA(At, 0, 0); PG8_STAGE(PG8_SA(1, 1), a1 + hA, voffA);
            PG8_WAIT_L(8); PG8_BAR; PG8_WAIT_L(0); PG8_MMA(0, 0, At, B0); PG8_BAR; PG8_SCHED;
            PG8_LDB(B1, 0, 1); PG8_STAGE(PG8_SB(0, 0), b2, voffB);
            PG8_BAR; PG8_WAIT_L(0); PG8_MMA(0, 1, At, B1); PG8_BAR;
            PG8_LDA(At, 0, 1); PG8_STAGE(PG8_SA(0, 0), a2, voffA);
            PG8_BAR; PG8_WAIT_L(0); PG8_MMA(1, 0, At, B0); PG8_BAR; PG8_SCHED;
            PG8_STAGE(PG8_SB(0, 1), b2 + hB, voffB);
            PG8_WAIT_V(6); PG8_BAR; PG8_MMA(1, 1, At, B1); PG8_BAR;
            PG8_LDB(B0, 1, 0); PG8_SCHED; PG8_LDA(At, 1, 0); PG8_STAGE(PG8_SA(0, 1), a2 + hA, voffA);
            PG8_WAIT_L(8); PG8_BAR; PG8_WAIT_L(0); PG8_MMA(0, 0, At, B0); PG8_BAR; PG8_SCHED;
            PG8_LDB(B1, 1, 1); PG8_STAGE(PG8_SB(1, 0), b3, voffB);
            PG8_BAR; PG8_WAIT_L(0); PG8_MMA(0, 1, At, B1); PG8_BAR;
            PG8_LDA(At, 1, 1); PG8_STAGE(PG8_SA(1, 0), a3, voffA);
            PG8_BAR; PG8_WAIT_L(0); PG8_MMA(1, 0, At, B0); PG8_BAR; PG8_SCHED;
            PG8_STAGE(PG8_SB(1, 1), b3 + hB, voffB);
            PG8_WAIT_V(6); PG8_BAR; PG8_MMA(1, 1, At, B1); PG8_BAR;
            }
        }
        if constexpr (ALIGN_EPI) { if (wr == 0) PG8_BAR; }
        { int t2 = threadIdx.x; asm volatile("" : "+v"(t2)); const int w2 = t2 >> 6, l2 = t2 & 63; E(acc, cur, w2 >> 2, w2 & 3, l2 & 15, l2 >> 4); }
        if (!has_next) break;
#pragma unroll
        for (int a = 0; a < 2; ++a)
#pragma unroll
            for (int b = 0; b < 2; ++b)
#pragma unroll
                for (int m = 0; m < 4; ++m)
#pragma unroll
                    for (int n = 0; n < 2; ++n) acc[a][b][m][n] = (f32x4){0.f, 0.f, 0.f, 0.f};
        cur = nxt; cA = nA; cB = nB; ++ui;
        if constexpr (ALIGN_EPI) { if (wr == 1) PG8_BAR; }
    }
    PG8_WAIT_V(0);
    if constexpr (!ALIGN_EPI) { if (wr == 0) PG8_BAR; }
    PG8_BAR;
#undef PG8_SA
#undef PG8_SB
#undef PG8_STAGE
#undef PG8_LDA
#undef PG8_LDB
#undef PG8_MMA
#undef PG8_WAIT_V
#undef PG8_WAIT_L
#undef PG8_BAR
#undef PG8_SCHED
#undef PG8_OFFA
#undef PG8_OFFB
}
}

typedef f32x4 AccT[2][2][4][2];

template <int MODE, bool NORM = false> struct EpiBf16 {
    static constexpr bool PERM = true;
    bf16_t* O; bf16_t* O2; int ldc; const float* ss; const float* sw;
    __device__ __forceinline__ void operator()(const AccT& acc, const pg8::Unit& u, int wr, int wc, int fr, int fq) const {
        const int row0 = u.pm * 256 + wr * 64 + fr; int colt = u.pn * 256; bf16_t* base = O; bool act = (MODE == 1);
        if (MODE == 2) { if (colt >= 1024) { colt -= 1024; base = O2; act = true; } }
        const int col0 = colt + wc * 32 + 8 * fq;
        f32x4 sv[2][2];
        if (NORM) { const float* swp = sw + (size_t)cond_of_tile(u.pm) * 6144 + u.pn * 256 + wc * 32 + 8 * fq;
#pragma unroll
            for (int bj = 0; bj < 2; ++bj) { sv[bj][0] = *(const f32x4*)(swp + bj * 128); sv[bj][1] = *(const f32x4*)(swp + bj * 128 + 4); } }
        float rsd[2][4];
        if (NORM) { f32x4 t[2][4]; const int lane = fq * 16 + fr;
#pragma unroll
            for (int ai = 0; ai < 2; ++ai)
#pragma unroll
                for (int m = 0; m < 4; ++m) t[ai][m] = *(const f32x4*)(ss + (size_t)(row0 + ai * 128 + m * 16) * 16 + 4 * fq);
#pragma unroll
            for (int ai = 0; ai < 2; ++ai)
#pragma unroll
                for (int m = 0; m < 4; ++m) { float q = (t[ai][m][0] + t[ai][m][1]) + (t[ai][m][2] + t[ai][m][3]); q += shfl_xor_l(q, lane, 16); q += shfl_xor_l(q, lane, 32);
                    rsd[ai][m] = rsqrtf(q * (1.f / 1024.f) + 1e-6f); } }
#pragma unroll
        for (int ai = 0; ai < 2; ++ai)
#pragma unroll
            for (int m = 0; m < 4; ++m) { const int row = row0 + ai * 128 + m * 16; bf16_t* rowp = base + (size_t)row * ldc + col0;
                float rstd = 1.f;
                if (NORM) rstd = rsd[ai][m];
#pragma unroll
                for (int bj = 0; bj < 2; ++bj) { f32x4 v0 = acc[ai][bj][m][0], v1 = acc[ai][bj][m][1];
                    if (NORM) { v0 = v0 * rstd + sv[bj][0]; v1 = v1 * rstd + sv[bj][1]; }
                    if (act) {
#pragma unroll
                        for (int j = 0; j < 4; ++j) {
                            if (MODE == 1) { float a = fmaxf(v0[j], 0.f), b = fmaxf(v1[j], 0.f); v0[j] = a * a; v1[j] = b * b; }
                            else { float x = v0[j], y = v1[j];
                                   float ux = 1.5957691216f * (x + 0.044715f * x * x * x), uy = 1.5957691216f * (y + 0.044715f * y * y * y);
                                   v0[j] = x * __builtin_amdgcn_rcpf(1.f + __expf(-ux)); v1[j] = y * __builtin_amdgcn_rcpf(1.f + __expf(-uy)); }
                        }
                    }
                    u32x4 w; w.x = pg8::cvt_pk_bf16(v0[0], v0[1]); w.y = pg8::cvt_pk_bf16(v0[2], v0[3]); w.z = pg8::cvt_pk_bf16(v1[0], v1[1]); w.w = pg8::cvt_pk_bf16(v1[2], v1[3]);
                    *(u32x4*)(rowp + bj * 128) = w; } }
    }
};
struct EpiF32 {
    static constexpr bool PERM = false;
    float* O; int ldc; const float* ss; const float* sw;
    __device__ __forceinline__ void operator()(const AccT& acc, const pg8::Unit& u, int wr, int wc, int fr, int fq) const {
        const int row0 = u.pm * 256 + wr * 64 + fr, col0 = u.pn * 256 + wc * 32 + 4 * fq;
        const float* swp = sw + (size_t)cond_of_tile(u.pm) * 6144 + col0;
        f32x4 sv[2][2];
#pragma unroll
        for (int bj = 0; bj < 2; ++bj)
#pragma unroll
            for (int n = 0; n < 2; ++n) sv[bj][n] = *(const f32x4*)(swp + bj * 128 + n * 16);
        float rsd[2][4];
        { f32x4 t[2][4]; const int lane = fq * 16 + fr;
#pragma unroll
            for (int ai = 0; ai < 2; ++ai)
#pragma unroll
                for (int m = 0; m < 4; ++m) t[ai][m] = *(const f32x4*)(ss + (size_t)(row0 + ai * 128 + m * 16) * 16 + 4 * fq);
#pragma unroll
            for (int ai = 0; ai < 2; ++ai)
#pragma unroll
                for (int m = 0; m < 4; ++m) { float q = (t[ai][m][0] + t[ai][m][1]) + (t[ai][m][2] + t[ai][m][3]); q += shfl_xor_l(q, lane, 16); q += shfl_xor_l(q, lane, 32);
                    rsd[ai][m] = rsqrtf(q * (1.f / 1024.f) + 1e-6f); } }
#pragma unroll
        for (int ai = 0; ai < 2; ++ai)
#pragma unroll
            for (int m = 0; m < 4; ++m) { const int row = row0 + ai * 128 + m * 16; float* rowp = O + (size_t)row * ldc + col0;
                const float rstd = rsd[ai][m];
#pragma unroll
                for (int bj = 0; bj < 2; ++bj)
#pragma unroll
                    for (int n = 0; n < 2; ++n) *(f32x4*)(rowp + bj * 128 + n * 16) = acc[ai][bj][m][n] * rstd + sv[bj][n]; }
    }
};
struct EpiResid {
    static constexpr bool PERM = true;
    const float* base0; const float* base1; float* out; const float* gate;
    bf16_t* XG; const float* gn; const float* sc; float* ss;
    __device__ __forceinline__ void operator()(const AccT& acc, const pg8::Unit& u, int wr, int wc, int fr, int fq) const {
        const int row0 = u.pm * 256 + wr * 64 + fr, col0 = u.pn * 256 + wc * 32 + 8 * fq, cnd = cond_of_tile(u.pm), lane = fq * 16 + fr;
        const float* gp = gate + (size_t)cnd * 6144 + col0;
        const float* bp = (u.pm < 16) ? base0 : base1 - (size_t)MCTX * D;
        const bool xg = XG != nullptr;
        f32x4 gv[2][2], gm[2][2]; float sqa[2][4];
#pragma unroll
        for (int bj = 0; bj < 2; ++bj)
#pragma unroll
            for (int n = 0; n < 2; ++n) { gv[bj][n] = *(const f32x4*)(gp + bj * 128 + n * 4);
                if (xg) gm[bj][n] = *(const f32x4*)(gn + col0 + bj * 128 + n * 4) * (*(const f32x4*)(sc + (size_t)cnd * 6144 + col0 + bj * 128 + n * 4) + 1.f);
                else gm[bj][n] = (f32x4){0.f, 0.f, 0.f, 0.f}; }
#pragma unroll
        for (int aim = 0; aim < 4; ++aim) { const int ai = aim >> 1, mb = (aim & 1) * 2;
            f32x4 bb[4][2][2];
#pragma unroll
            for (int m = mb; m < mb + 2; ++m)
#pragma unroll
                for (int bj = 0; bj < 2; ++bj)
#pragma unroll
                    for (int n = 0; n < 2; ++n) bb[m][bj][n] = *(const f32x4*)(bp + (size_t)(row0 + ai * 128 + m * 16) * D + col0 + bj * 128 + n * 4);
#pragma unroll
            for (int m = mb; m < mb + 2; ++m) { const int row = row0 + ai * 128 + m * 16; const size_t off = (size_t)row * D + col0; float sq = 0.f;
#pragma unroll
                for (int bj = 0; bj < 2; ++bj) {
                    const f32x4 x0 = bb[m][bj][0] + gv[bj][0] * acc[ai][bj][m][0], x1 = bb[m][bj][1] + gv[bj][1] * acc[ai][bj][m][1];
                    *(f32x4*)(out + off + bj * 128) = x0; *(f32x4*)(out + off + bj * 128 + 4) = x1;
                    if (xg) { sq += ((x0[0] * x0[0] + x0[1] * x0[1]) + (x0[2] * x0[2] + x0[3] * x0[3])) + ((x1[0] * x1[0] + x1[1] * x1[1]) + (x1[2] * x1[2] + x1[3] * x1[3]));
                        const f32x4 y0 = x0 * gm[bj][0], y1 = x1 * gm[bj][1];
                        *(u32x4*)(XG + off + bj * 128) = (u32x4){pg8::cvt_pk_bf16(y0[0], y0[1]), pg8::cvt_pk_bf16(y0[2], y0[3]), pg8::cvt_pk_bf16(y1[0], y1[1]), pg8::cvt_pk_bf16(y1[2], y1[3])}; } }
                sqa[ai][m] = sq; }
        }
        if (xg) {
#pragma unroll
            for (int ai = 0; ai < 2; ++ai)
#pragma unroll
                for (int m = 0; m < 4; ++m) sqa[ai][m] += shfl_xor_l(sqa[ai][m], lane, 16);
#pragma unroll
            for (int ai = 0; ai < 2; ++ai)
#pragma unroll
                for (int m = 0; m < 4; ++m) sqa[ai][m] += shfl_xor_l(sqa[ai][m], lane, 32);
            if (fq == 0) {
#pragma unroll
                for (int ai = 0; ai < 2; ++ai)
#pragma unroll
                    for (int m = 0; m < 4; ++m) ss[(size_t)(row0 + ai * 128 + m * 16) * 16 + u.pn * 4 + wc] = sqa[ai][m]; }
        }
    }
};
struct EpiGates {
    static constexpr bool PERM = true;
    const bf16_t* XC; unsigned* AB; const float* ba; const float* bx; const float* sp;
    __device__ __forceinline__ void operator()(const AccT& acc, const pg8::Unit& u, int wr, int wc, int fr, int fq) const {
        const int blk = u.pn >> 1, dir = u.pn & 1;
        const int row0 = u.pm * 256 + wr * 64 + fr, ch0 = blk * 128 + wc * 32 + 8 * fq;
        unsigned* ab = AB + (size_t)dir * M * 1024;
        u32x2 xwa[2][2][4];
#pragma unroll
        for (int n = 0; n < 2; ++n)
#pragma unroll
            for (int ai = 0; ai < 2; ++ai)
#pragma unroll
                for (int m = 0; m < 4; ++m) xwa[n][ai][m] = *(const u32x2*)(XC + (size_t)(row0 + ai * 128 + m * 16) * 1024 + ch0 + 4 * n);
#pragma unroll
        for (int n = 0; n < 2; ++n) {
            const f32x4 vba = *(const f32x4*)(ba + dir * 1024 + ch0 + 4 * n), vbx = *(const f32x4*)(bx + dir * 1024 + ch0 + 4 * n), vsp = *(const f32x4*)(sp + dir * 1024 + ch0 + 4 * n);
#pragma unroll
            for (int ai = 0; ai < 2; ++ai)
#pragma unroll
                for (int m = 0; m < 4; ++m) { const size_t off = (size_t)(row0 + ai * 128 + m * 16) * 1024 + ch0 + 4 * n;
                    const u32x2 xw = xwa[n][ai][m];
                    const float xf[4] = {bflo(xw.x), bfhi(xw.x), bflo(xw.y), bfhi(xw.y)};
                    unsigned o[4];
#pragma unroll
                    for (int j = 0; j < 4; ++j) {
                        const float r = sigmoidf_(acc[ai][0][m][n][j] + vba[j]);
                        const float la = -r * vsp[j];
                        const float uu = fmaxf(1.f - __expf(2.f * la), 1e-20f), vv = 1.f + __expf(-(acc[ai][1][m][n][j] + vbx[j]));
                        const float bb = uu * __builtin_amdgcn_rsqf(uu * vv * vv) * xf[j];
                        o[j] = pk2(la, bb); }
                    *(u32x4*)(ab + off) = (u32x4){o[0], o[1], o[2], o[3]};
                    __builtin_amdgcn_sched_barrier(0); }
        }
    }
};
struct EpiQ {
    static constexpr bool PERM = true;
    bf16_t* Q; const float* rope; float qscale;
    __device__ __forceinline__ void operator()(const AccT& acc, const pg8::Unit& u, int wr, int wc, int fr, int fq) const {
        const int row0 = u.pm * 256 + wr * 64 + fr;
#pragma unroll
        for (int bj = 0; bj < 2; ++bj) {
            const int col0 = u.pn * 256 + bj * 128 + wc * 32 + 8 * fq; const int within = col0 % 192;
            const bool pe = (within >= 128) && (u.pm >= 16); const int i0 = pe ? ((within - 128) >> 1) : 0;
            bf16_t* qp = Q + (size_t)row0 * QW + col0;
            const float* rp0 = rope + (size_t)i0 * 2;
#pragma unroll
            for (int ai = 0; ai < 2; ++ai)
#pragma unroll
                for (int m = 0; m < 4; ++m) { const int rr = ai * 128 + m * 16;
                    f32x4 v0 = acc[ai][bj][m][0], v1 = acc[ai][bj][m][1];
                    if (pe) { const int pos = (row0 + rr - MCTX) & 2047; const float* rp = rp0 + (size_t)pos * 64;
                        const f32x4 r0 = *(const f32x4*)rp, r1 = *(const f32x4*)(rp + 4);
                        const f32x4 a = v0, b = v1;
                        v0[0] = a[0] * r0[0] - a[1] * r0[1]; v0[1] = a[0] * r0[1] + a[1] * r0[0];
                        v0[2] = a[2] * r0[2] - a[3] * r0[3]; v0[3] = a[2] * r0[3] + a[3] * r0[2];
                        v1[0] = b[0] * r1[0] - b[1] * r1[1]; v1[1] = b[0] * r1[1] + b[1] * r1[0];
                        v1[2] = b[2] * r1[2] - b[3] * r1[3]; v1[3] = b[2] * r1[3] + b[3] * r1[2]; }
                    v0 = v0 * qscale; v1 = v1 * qscale;
                    u32x4 w; w.x = pg8::cvt_pk_bf16(v0[0], v0[1]); w.y = pg8::cvt_pk_bf16(v0[2], v0[3]); w.z = pg8::cvt_pk_bf16(v1[0], v1[1]); w.w = pg8::cvt_pk_bf16(v1[2], v1[3]);
                    *(u32x4*)(qp + (size_t)rr * QW) = w;
                    __builtin_amdgcn_sched_barrier(0); }
        }
    }
};

__device__ __forceinline__ void rstd_prepass(LAS float* rs, const float* ss, int Mr, int N) {
    pg8::StaticOrder S; S.init(Mr, N, (int)gridDim.x, opaque_bid());
    const int tid = opaque_tid(), lane = tid & 63, rl = tid >> 1, half = tid & 1;
    pg8::Unit u;
    for (int i = 0; S.next(i, u); ++i) {
        const float* sp = ss + (size_t)(u.pm * 256 + rl) * 16 + half * 8;
        const f32x4 a = *(const f32x4*)sp, b = *(const f32x4*)(sp + 4); const f32x4 t4 = a + b;
        float t = (t4[0] + t4[1]) + (t4[2] + t4[3]); t += shfl_xor_l(t, lane, 1);
        if (half == 0) rs[i * 256 + rl] = rsqrtf(t * (1.f / 1024.f) + 1e-6f);
    }
    __syncthreads();
}
template <class Epi>
__device__ __forceinline__ void run_gemm(LAS unsigned char* lds, const bf16_t* A, int lda, const bf16_t* Bt, int ldb, int Mr, int N, int K, int a_sh, int a_colbytes, const Epi& E, int lim = 1 << 30) {
    pg8::Gemm g{A, Bt, lda, ldb, K, a_sh, a_colbytes, 0, nullptr, nullptr};
    pg8::StaticOrder S; S.init(Mr, N, (int)gridDim.x, opaque_bid()); if (lim < S.lim) S.lim = lim;
    pg8::gemm_phase<Epi, pg8::StaticOrder, true, true>(lds, g, S, E);
}
struct EpiDual {
    static constexpr bool PERM = true;
    bf16_t* O0; int ld0; bf16_t* O1; int ld1;
    __device__ __forceinline__ void operator()(const AccT& acc, const pg8::Unit& u, int wr, int wc, int fr, int fq) const {
        bf16_t* base = u.which ? O1 : O0; const int ldc = u.which ? ld1 : ld0;
        const int row0 = u.pm * 256 + wr * 64 + fr, col0 = u.pn * 256 + wc * 32 + 8 * fq;
#pragma unroll
        for (int ai = 0; ai < 2; ++ai)
#pragma unroll
            for (int m = 0; m < 4; ++m) { bf16_t* rowp = base + (size_t)(row0 + ai * 128 + m * 16) * ldc + col0;
#pragma unroll
                for (int bj = 0; bj < 2; ++bj) { const f32x4 v0 = acc[ai][bj][m][0], v1 = acc[ai][bj][m][1];
                    u32x4 w; w.x = pg8::cvt_pk_bf16(v0[0], v0[1]); w.y = pg8::cvt_pk_bf16(v0[2], v0[3]); w.z = pg8::cvt_pk_bf16(v1[0], v1[1]); w.w = pg8::cvt_pk_bf16(v1[2], v1[3]);
                    *(u32x4*)(rowp + bj * 128) = w; } }
    }
};
__device__ __forceinline__ void run_gemm_dual(LAS unsigned char* lds, const bf16_t* A0, const bf16_t* B0, int M0, int N0, const bf16_t* A1, const bf16_t* B1, int M1, int N1, int ld, int K, const EpiDual& E) {
    pg8::Gemm g{A0, B0, ld, ld, K, 0, 0, 0, A1, B1};
    pg8::DualOrder S{M0 / 256, N0 / 256, M1 / 256, N1 / 256, (int)gridDim.x, opaque_bid()};
    pg8::gemm_phase<EpiDual, pg8::DualOrder, true, true>(lds, g, S, E);
}
struct EpiPartial {
    static constexpr bool PERM = false;
    float* part; int base, nM, nN;
    __device__ __forceinline__ void operator()(const AccT& acc, const pg8::Unit& u, int wr, int wc, int fr, int fq) const {
        const int slot = opaque_bid();
        float* O = part + (size_t)slot * 65536;
        const int row0 = wr * 64 + fr, col0 = wc * 32 + 4 * fq;
#pragma unroll
        for (int ai = 0; ai < 2; ++ai)
#pragma unroll
            for (int m = 0; m < 4; ++m) { float* rowp = O + (size_t)(row0 + ai * 128 + m * 16) * 256 + col0;
#pragma unroll
                for (int bj = 0; bj < 2; ++bj)
#pragma unroll
                    for (int n = 0; n < 2; ++n) *(f32x4*)(rowp + bj * 128 + n * 16) = acc[ai][bj][m][n]; }
    }
};
template <class Epi>
__device__ __forceinline__ void run_gemm_split(LAS unsigned char* lds, const bf16_t* A, int lda, const bf16_t* Bt, int ldb, int Mr, int N, int Kq, int base, const Epi& E) {
    pg8::Gemm g{A, Bt, lda, ldb, Kq, 0, 0, Kq * 2, nullptr, nullptr};
    pg8::SplitOrder S{Mr / 256, N / 256, base, opaque_bid()};
    pg8::gemm_phase<Epi, pg8::SplitOrder, true, true>(lds, g, S, E);
}
__device__ __forceinline__ void split_reduce_phase(const float* part, float* X, const float* gate, int base, int nM, int nN, bf16_t* XG, const float* gn, const float* sc, float* ss) {
    const int tid_ = opaque_tid(), lane = tid_ & 63; const int gt = opaque_bid() * 512 + tid_, NT = gridDim.x * 512;
    const int nsplit = nM * nN - base, nit = nsplit * 16384;
    for (int it0 = gt; it0 < nit; it0 += 4 * NT) {
        f32x4 p[4][4], xo[4], gv[4], gm[4]; int rowv[4], colv[4], pnv[4]; bool ok[4];
#pragma unroll
        for (int i = 0; i < 4; ++i) { const int it = it0 + i * NT; ok[i] = it < nit;
            const int itc = ok[i] ? it : it0;
            const int su = itc >> 14, e = itc & 16383, r = e >> 6, c4 = (e & 63) * 4;
            pg8::Unit u; pg8::unit_of(base + su, nM, nN, u);
            const float* pp = part + (size_t)su * 4 * 65536 + r * 256 + c4;
#pragma unroll
            for (int k4 = 0; k4 < 4; ++k4) p[i][k4] = *(const f32x4*)(pp + (size_t)k4 * 65536);
            rowv[i] = u.pm * 256 + r; colv[i] = u.pn * 256 + c4; pnv[i] = u.pn; const int cnd = cond_of_tile(u.pm);
            xo[i] = *(const f32x4*)(X + (size_t)rowv[i] * D + colv[i]);
            gv[i] = *(const f32x4*)(gate + (size_t)cnd * 6144 + colv[i]);
            if (XG != nullptr) gm[i] = *(const f32x4*)(gn + colv[i]) * (*(const f32x4*)(sc + (size_t)cnd * 6144 + colv[i]) + 1.f); else gm[i] = (f32x4){0.f, 0.f, 0.f, 0.f}; }
        float sq[4];
#pragma unroll
        for (int i = 0; i < 4; ++i) { const f32x4 s4 = (p[i][0] + p[i][1]) + (p[i][2] + p[i][3]); const f32x4 xn = xo[i] + gv[i] * s4;
            if (ok[i]) *(f32x4*)(X + (size_t)rowv[i] * D + colv[i]) = xn;
            sq[i] = (xn[0] * xn[0] + xn[1] * xn[1]) + (xn[2] * xn[2] + xn[3] * xn[3]);
            if (XG != nullptr && ok[i]) { const f32x4 y = xn * gm[i]; *(u32x2*)(XG + (size_t)rowv[i] * D + colv[i]) = (u32x2){pk2(y[0], y[1]), pk2(y[2], y[3])}; } }
        if (XG != nullptr) {
#pragma unroll
            for (int o_ = 1; o_ < 64; o_ <<= 1) {
#pragma unroll
                for (int i = 0; i < 4; ++i) sq[i] += shfl_xor_l(sq[i], lane, o_); }
#pragma unroll
            for (int i = 0; i < 4; ++i) if (ok[i] && lane < 4) ss[(size_t)rowv[i] * 16 + pnv[i] * 4 + lane] = lane == 0 ? sq[i] : 0.f;
        }
    }
}
__device__ __forceinline__ void sw_phase(const float* mod, const unsigned char* ws, float* sW) {
    const int tid_ = opaque_tid(), lane = tid_ & 63, gw = opaque_bid() * 8 + (tid_ >> 6), NGW = gridDim.x * 8;
    const int r16 = lane & 15, q = lane >> 4;
    for (int it = gw; it < 1408; it += NGW) {
        int l = 0, n0 = 0; bool up = false;
        { int r = it;
          for (int ll = 0; ll < 4; ++ll) { const int nmix = (ll & 1) ? 64 : 128;
              if (r < nmix) { l = ll; n0 = r * 16; up = false; break; } r -= nmix;
              if (r < 256) { l = ll; n0 = r * 16; up = true; break; } r -= 256; } }
        const int j = l >> 1;
        const bf16_t* wt;
        if (up) wt = (const bf16_t*)(ws + WS_W1T) + ((size_t)l * 4096 + n0) * 1024;
        else if (l & 1) wt = (const bf16_t*)(ws + WS_WDQT) + ((size_t)j * 1024 + n0) * 1024;
        else wt = (const bf16_t*)(ws + WS_WINT) + ((size_t)j * 2048 + n0) * 1024;
        const bf16_t* wp = wt + (size_t)r16 * 1024 + 8 * q;
        const bool cv = r16 < 9;
        const float* shp = mod + ((size_t)l * 9 + (cv ? r16 : 0)) * 6144 + (up ? 3 : 0) * 1024 + 8 * q;
        f32x4 acc = (f32x4){0.f, 0.f, 0.f, 0.f};
#pragma unroll 1
        for (int kb = 0; kb < 4; ++kb) {
            bf16x8 bfr[8]; f32x4 a0[8], a1[8];
#pragma unroll
            for (int s8 = 0; s8 < 8; ++s8) { const int k0 = kb * 256 + s8 * 32;
                bfr[s8] = *(const bf16x8*)(wp + k0); a0[s8] = *(const f32x4*)(shp + k0); a1[s8] = *(const f32x4*)(shp + k0 + 4); }
#pragma unroll
            for (int s8 = 0; s8 < 8; ++s8) { u32x4 aw;
                aw.x = pk2(a0[s8][0], a0[s8][1]); aw.y = pk2(a0[s8][2], a0[s8][3]); aw.z = pk2(a1[s8][0], a1[s8][1]); aw.w = pk2(a1[s8][2], a1[s8][3]);
                if (!cv) aw = (u32x4){0u, 0u, 0u, 0u};
                acc = __builtin_amdgcn_mfma_f32_16x16x32_bf16(__builtin_bit_cast(bf16x8, aw), bfr[s8], acc, 0, 0, 0); }
        }
#pragma unroll
        for (int i = 0; i < 4; ++i) { const int cnd = 4 * q + i; if (cnd < 9) sW[((size_t)l * 9 + cnd) * 6144 + (up ? 2048 : 0) + n0 + r16] = acc[i]; }
    }
}

struct Params { const float* in[29]; float* out; unsigned char* ws; int ph_lo, ph_hi; };
enum { I_XP = 0, I_XS, I_STATE, I_CCKV, I_CKPE, I_C, I_CCTX, I_ADAW, I_ADAB, I_NMIX, I_NMLP, I_W1, I_W2, I_WIN, I_CONVW, I_CONVB, I_WA, I_BA, I_WX, I_BX, I_LAM, I_WOUT,
       I_WDQ, I_NQ, I_NKV, I_WUQ, I_WUKV, I_WO, I_FN };

__device__ __forceinline__ void transpose_item(const float* src, int ldsrc, int k0, int n0, bf16_t* dstrow0, int lddst, LAS float* scr, int lane) {
    float tv[32];
#pragma unroll
    for (int i = 0; i < 32; ++i) { const int kk = 2 * i + (lane >> 5); tv[i] = src[(size_t)(k0 + kk) * ldsrc + n0 + (lane & 31)]; }
#pragma unroll
    for (int i = 0; i < 32; ++i) { const int kk = 2 * i + (lane >> 5); scr[kk * 33 + (lane & 31)] = tv[i]; }
    asm volatile("s_waitcnt lgkmcnt(0)" ::: "memory");
    const int c = lane & 7;
#pragma unroll
    for (int j = 0; j < 4; ++j) { const int n = (lane >> 3) + 8 * j; const LAS float* s = scr + (8 * c) * 33 + n;
        u32x4 o; o.x = pk2(s[0 * 33], s[1 * 33]); o.y = pk2(s[2 * 33], s[3 * 33]); o.z = pk2(s[4 * 33], s[5 * 33]); o.w = pk2(s[6 * 33], s[7 * 33]);
        *(u32x4*)(dstrow0 + (size_t)n * lddst + k0 + 8 * c) = o; }
    asm volatile("s_waitcnt lgkmcnt(0)" ::: "memory");
}

__device__ __forceinline__ void phase0(KArgP pk, LAS unsigned char* lds) {
    const int tid = opaque_tid(), lane = tid & 63, wave = tid >> 6, bid = opaque_bid();
    const int G = gridDim.x, gw = bid * 8 + wave, NGW = G * 8;
    unsigned char* ws = pk->ws;
    {
        const int gt = bid * 512 + tid, NT = G * 512;
        float2* rope = (float2*)(ws + WS_ROPE);
        for (int e = gt; e < 2048 * 32; e += NT) { const int pos = e >> 5, i = e & 31;
            const float inv = exp2f(-(float)(i & 15) * 0.83048202372f);
            const float ang = (float)(i < 16 ? (pos >> 6) : (pos & 63)) * inv;
            float rev = ang * 0.15915494309f; rev -= floorf(rev);
            rope[e] = make_float2(__builtin_amdgcn_cosf(rev), __builtin_amdgcn_sinf(rev)); }
        float* sp = (float*)(ws + WS_SP);
        for (int e = gt; e < 2 * 2 * 1024; e += NT) sp[e] = 8.f * log1pf(__expf(-pk->in[I_LAM][e]));
        for (int e = gt; e < 2 * 192 * 128; e += NT) { const int j = e / (192 * 128), r = e % (192 * 128);
            ((u32x4*)(ws + WS_WDQT + (size_t)j * 2 * MiB + (size_t)832 * 1024 * 2))[r] = (u32x4){0u, 0u, 0u, 0u}; }
    }
    {
        LAS float* scr = (LAS float*)(lds + wave * 16384);
        constexpr int IT_W1 = 16 * 128, IT_W2 = 64 * 32, IT_WIN = 16 * 64, IT_SQ = 16 * 32, IT_G = 8, IT_DQ = 16 * 26, IT_UQ = 8 * 48, IT_UKV = 4 * 64;
        constexpr int N1 = 4 * IT_W1, N2 = 4 * IT_W2, N3 = 2 * IT_WIN, N4 = 2 * IT_SQ, N5 = 64 * IT_G, N6 = 2 * IT_DQ, N7 = 2 * IT_UQ, N8 = 2 * IT_UKV, N9 = 2 * IT_SQ;
        constexpr int NITEMS = N1 + N2 + N3 + N4 + N5 + N6 + N7 + N8 + N9;
        for (int it = gw; it < NITEMS; it += NGW) {
            int r = it;
            if (r < N1) { const int l = r / IT_W1, q = r % IT_W1, kb = q / 128, nb = q % 128;
                transpose_item(pk->in[I_W1] + (size_t)l * 1024 * 4096, 4096, kb * 64, nb * 32, (bf16_t*)(ws + WS_W1T) + ((size_t)l * 4096 + nb * 32) * 1024, 1024, scr, lane); continue; } r -= N1;
            if (r < N2) { const int l = r / IT_W2, q = r % IT_W2, kb = q / 32, nb = q % 32;
                transpose_item(pk->in[I_W2] + (size_t)l * 4096 * 1024, 1024, kb * 64, nb * 32, (bf16_t*)(ws + WS_W2T) + ((size_t)l * 1024 + nb * 32) * 4096, 4096, scr, lane); continue; } r -= N2;
            if (r < N3) { const int j = r / IT_WIN, q = r % IT_WIN, kb = q / 64, nb = q % 64;
                transpose_item(pk->in[I_WIN] + (size_t)j * 1024 * 2048, 2048, kb * 64, nb * 32, (bf16_t*)(ws + WS_WINT) + ((size_t)j * 2048 + nb * 32) * 1024, 1024, scr, lane); continue; } r -= N3;
            if (r < N4) { const int j = r / IT_SQ, q = r % IT_SQ, kb = q / 32, nb = q % 32;
                transpose_item(pk->in[I_WOUT] + (size_t)j * 1024 * 1024, 1024, kb * 64, nb * 32, (bf16_t*)(ws + WS_WOUTT) + ((size_t)j * 1024 + nb * 32) * 1024, 1024, scr, lane); continue; } r -= N4;
            if (r < N5) { const int mat = r / IT_G, q = r % IT_G, kb = q / 4, nb = q % 4;
                const int which = mat & 1, blk = (mat >> 1) & 7, dir = (mat >> 4) & 1, j = mat >> 5;
                const float* src = (which ? pk->in[I_WX] : pk->in[I_WA]) + (size_t)(((j * 2 + dir) * 8 + blk)) * 128 * 128;
                bf16_t* dst = (bf16_t*)(ws + WS_WGT) + ((size_t)j * 4096 + (blk * 2 + dir) * 256 + which * 128 + nb * 32) * 128;
                transpose_item(src, 128, kb * 64, nb * 32, dst, 128, scr, lane); continue; } r -= N5;
            if (r < N6) { const int j = r / IT_DQ, q = r % IT_DQ, kb = q / 26, nb = q % 26;
                transpose_item(pk->in[I_WDQ] + (size_t)j * 1024 * 832, 832, kb * 64, nb * 32, (bf16_t*)(ws + WS_WDQT) + ((size_t)j * 1024 + nb * 32) * 1024, 1024, scr, lane); continue; } r -= N6;
            if (r < N7) { const int j = r / IT_UQ, q = r % IT_UQ, kb = q / 48, nb = q % 48;
                transpose_item(pk->in[I_WUQ] + (size_t)j * 512 * 1536, 1536, kb * 64, nb * 32, (bf16_t*)(ws + WS_WUQT) + ((size_t)j * 1536 + nb * 32) * 512, 512, scr, lane); continue; } r -= N7;
            if (r < N8) { const int j = r / IT_UKV, q = r % IT_UKV, kb = q / 64, nb = q % 64;
                const int n0 = nb * 32, head = n0 >> 8, within = n0 & 255;
                bf16_t* dst = within < 128 ? (bf16_t*)(ws + WS_WUKT) + ((size_t)j * 1024 + head * 128 + within) * 256
                                           : (bf16_t*)(ws + WS_WUVT) + ((size_t)j * 1024 + head * 128 + within - 128) * 256;
                transpose_item(pk->in[I_WUKV] + (size_t)j * 256 * 2048, 2048, kb * 64, n0, dst, 256, scr, lane); continue; } r -= N8;
            { const int j = r / IT_SQ, q = r % IT_SQ, kb = q / 32, nb = q % 32;
                transpose_item(pk->in[I_WO] + (size_t)j * 1024 * 1024, 1024, kb * 64, nb * 32, (bf16_t*)(ws + WS_WOT) + ((size_t)j * 1024 + nb * 32) * 1024, 1024, scr, lane); }
        }
    }
    __syncthreads();
    {
        LAS float* sl = (LAS float*)lds;
        LAS float* red = (LAS float*)(lds + 36864);
        for (int e = tid; e < 9 * 1024; e += 512) { const int cnd = e >> 10, k = e & 1023;
            const float v = cnd == 0 ? pk->in[I_CCTX][k] : pk->in[I_C][(cnd - 1) * 1024 + k]; sl[e] = v / (1.f + __expf(-v)); }
        __syncthreads();
        float* mod = (float*)(ws + WS_MOD);
        const int half = lane >> 5, l32 = lane & 31;
        for (int unit = bid; unit < 4 * 48; unit += G) {
            const int l = unit / 48, cb = unit % 48, col = cb * 128 + l32 * 4;
            const float* w = pk->in[I_ADAW] + (size_t)l * 1024 * 6144 + col;
            f32x4 acc[9];
#pragma unroll
            for (int c = 0; c < 9; ++c) acc[c] = (f32x4){0.f, 0.f, 0.f, 0.f};
            const int kbase = wave * 128 + half;
#pragma unroll 8
            for (int i = 0; i < 64; ++i) { const int k = kbase + 2 * i; const f32x4 wv = *(const f32x4*)(w + (size_t)k * 6144);
#pragma unroll
                for (int c = 0; c < 9; ++c) acc[c] += wv * sl[c * 1024 + k]; }
            const int part = wave * 2 + half;
#pragma unroll
            for (int c = 0; c < 9; ++c)
#pragma unroll
                for (int j = 0; j < 4; ++j) red[(part * 36 + c * 4 + j) * 32 + l32] = acc[c][j];
            __syncthreads();
            for (int o = tid; o < 9 * 128; o += 512) { const int c = o >> 7, cc = o & 127, ll = cc >> 2, j = cc & 3; float s = 0.f;
#pragma unroll
                for (int pp = 0; pp < 16; ++pp) s += red[(pp * 36 + c * 4 + j) * 32 + ll];
                mod[((size_t)l * 9 + c) * 6144 + cb * 128 + cc] = s + pk->in[I_ADAB][l * 6144 + cb * 128 + cc]; }
            __syncthreads();
        }
    }
}

__device__ __forceinline__ void norm_phase(const float* x0, const float* x1, const float* gn, const float* modl, int iscale, bf16_t* H, float* ss) {
    const int tid_ = opaque_tid(), lane = tid_ & 63, gw = opaque_bid() * 8 + (tid_ >> 6), NGW = gridDim.x * 8;
    f32x4 nv[4];
    if (gw < M) { const float* xr = gw < MCTX ? x0 + (size_t)gw * D : x1 + (size_t)(gw - MCTX) * D;
#pragma unroll
        for (int j = 0; j < 4; ++j) nv[j] = *(const f32x4*)(xr + 4 * lane + 256 * j); }
    for (int row = gw; row < M; row += NGW) {
        const int cnd = row < MCTX ? 0 : 1 + ((row - MCTX) >> 11);
        const float* sc = modl + (size_t)cnd * 6144 + iscale * 1024;
        f32x4 v[4]; float sq = 0.f;
#pragma unroll
        for (int j = 0; j < 4; ++j) v[j] = nv[j];
        const int rn = row + NGW;
        if (rn < M) { const float* xr = rn < MCTX ? x0 + (size_t)rn * D : x1 + (size_t)(rn - MCTX) * D;
#pragma unroll
            for (int j = 0; j < 4; ++j) nv[j] = *(const f32x4*)(xr + 4 * lane + 256 * j); }
#pragma unroll
        for (int j = 0; j < 4; ++j) sq += (v[j][0] * v[j][0] + v[j][1] * v[j][1]) + (v[j][2] * v[j][2] + v[j][3] * v[j][3]);
        sq = wave_sum(sq, lane);
        if (lane < 16) ss[(size_t)row * 16 + lane] = lane == 0 ? sq : 0.f;
#pragma unroll
        for (int j = 0; j < 4; ++j) { const int c = 4 * lane + 256 * j;
            const f32x4 g = *(const f32x4*)(gn + c), s_ = *(const f32x4*)(sc + c);
            const f32x4 y = v[j] * g * (s_ + 1.f);
            *(u32x2*)(H + (size_t)row * D + c) = (u32x2){pk2(y[0], y[1]), pk2(y[2], y[3])}; }
    }
}
__device__ __forceinline__ void final_norm_phase(float* X, const float* gn) {
    const int tid_ = opaque_tid(), lane = tid_ & 63, gw = opaque_bid() * 8 + (tid_ >> 6), NGW = gridDim.x * 8;
    f32x4 g[4];
#pragma unroll
    for (int j = 0; j < 4; ++j) g[j] = *(const f32x4*)(gn + 4 * lane + 256 * j);
    f32x4 nv[4];
    if (gw < M) {
#pragma unroll
        for (int j = 0; j < 4; ++j) nv[j] = *(const f32x4*)(X + (size_t)gw * D + 4 * lane + 256 * j); }
    for (int row = gw; row < M; row += NGW) {
        float* xr = X + (size_t)row * D;
        f32x4 v[4]; float ss = 0.f;
#pragma unroll
        for (int j = 0; j < 4; ++j) v[j] = nv[j];
        if (row + NGW < M) {
#pragma unroll
            for (int j = 0; j < 4; ++j) nv[j] = *(const f32x4*)(xr + (size_t)NGW * D + 4 * lane + 256 * j); }
#pragma unroll
        for (int j = 0; j < 4; ++j) ss += (v[j][0] * v[j][0] + v[j][1] * v[j][1]) + (v[j][2] * v[j][2] + v[j][3] * v[j][3]);
        const float rstd = rsqrtf(wave_sum(ss, lane) * (1.f / D) + 1e-6f);
#pragma unroll
        for (int j = 0; j < 4; ++j) *(f32x4*)(xr + 4 * lane + 256 * j) = v[j] * rstd * g[j];
    }
}
__device__ __forceinline__ void conv_phase(const bf16_t* XB, bf16_t* XC, const float* cw, const float* cb) {
    const int gt = opaque_bid() * 512 + opaque_tid(), NT = gridDim.x * 512;
    for (int it = gt; it < (M / 8) * 128; it += NT) {
        const int tg = it >> 7, cgp = it & 127, ch0 = cgp * 8, r0 = tg * 8;
        const int seqlen = r0 < MCTX ? 256 : 2048; const int t0 = r0 < MCTX ? (r0 & 255) : ((r0 - MCTX) & 2047);
        float w[4][8], bias[8];
#pragma unroll
        for (int k = 0; k < 4; ++k)
#pragma unroll
            for (int j = 0; j < 8; ++j) w[k][j] = cw[k * 1024 + ch0 + j];
#pragma unroll
        for (int j = 0; j < 8; ++j) bias[j] = cb[ch0 + j];
        float acc[8][8];
#pragma unroll
        for (int t = 0; t < 8; ++t)
#pragma unroll
            for (int j = 0; j < 8; ++j) acc[t][j] = bias[j];
#pragma unroll
        for (int s = 0; s < 11; ++s) {
            const int ts = t0 - 1 + s;
            u32x4 xw = (u32x4){0u, 0u, 0u, 0u};
            if (ts >= 0 && ts < seqlen) xw = *(const u32x4*)(XB + (size_t)(r0 - 1 + s) * 1024 + ch0);
            const float xf[8] = {bflo(xw.x), bfhi(xw.x), bflo(xw.y), bfhi(xw.y), bflo(xw.z), bfhi(xw.z), bflo(xw.w), bfhi(xw.w)};
#pragma unroll
            for (int k = 0; k < 4; ++k) { const int t = s - k;
                if (t >= 0 && t < 8) {
#pragma unroll
                    for (int j = 0; j < 8; ++j) acc[t][j] += w[k][j] * xf[j]; } }
        }
#pragma unroll
        for (int t = 0; t < 8; ++t)
            *(u32x4*)(XC + (size_t)(r0 + t) * 1024 + ch0) = (u32x4){pk2(acc[t][0], acc[t][1]), pk2(acc[t][2], acc[t][3]), pk2(acc[t][4], acc[t][5]), pk2(acc[t][6], acc[t][7])};
    }
}
__device__ __forceinline__ void scan1_phase(const unsigned* AB, float* car) {
    const int gt = opaque_bid() * 512 + opaque_tid(), NT = gridDim.x * 512;
    for (int it = gt; it < 2 * 640 * 256; it += NT) {
        const int cg4 = it & 255, c = (it >> 8) % 640, dir = it / (640 * 256);
        const unsigned* ab = AB + ((size_t)dir * M + c * 32) * 1024 + cg4 * 4;
        u32x4 v[32];
#pragma unroll
        for (int s = 0; s < 32; ++s) v[s] = *(const u32x4*)(ab + (size_t)s * 1024);
        asm volatile("" ::: "memory");
        float sl[4] = {0.f, 0.f, 0.f, 0.f}, h[4] = {0.f, 0.f, 0.f, 0.f};
        if (dir == 0) {
#pragma unroll
            for (int s = 0; s < 32; ++s) { const unsigned vv[4] = {v[s].x, v[s].y, v[s].z, v[s].w};
#pragma unroll
                for (int j = 0; j < 4; ++j) { const float la = bflo(vv[j]), b = bfhi(vv[j]); h[j] = __expf(la) * h[j] + b; sl[j] += la; } }
        } else {
#pragma unroll
            for (int s = 31; s >= 0; --s) { const unsigned vv[4] = {v[s].x, v[s].y, v[s].z, v[s].w};
#pragma unroll
                for (int j = 0; j < 4; ++j) { const float la = bflo(vv[j]), b = bfhi(vv[j]); h[j] = __expf(la) * h[j] + b; sl[j] += la; } }
        }
        float* o = car + (((size_t)dir * 640 + c) * 1024 + cg4 * 4) * 2;
        *(f32x4*)o = (f32x4){sl[0], h[0], sl[1], h[1]}; *(f32x4*)(o + 4) = (f32x4){sl[2], h[2], sl[3], h[3]};
    }
}
__device__ __forceinline__ void scan2_phase(float* car, const float* state_in  , int j, float* out_state) {
    const int gt = opaque_bid() * 512 + opaque_tid(), NT = gridDim.x * 512;
    for (int it = gt; it < 2 * 24 * 1024; it += NT) {
        const int ch = it & 1023, seq = (it >> 10) % 24, dir = it / (24 * 1024);
        const int c0 = seq < 16 ? seq * 8 : 128 + (seq - 16) * 64, nc = seq < 16 ? 8 : 64;
        float h = seq < 16 ? 0.f : state_in[(((size_t)(seq - 16) * 2 + j) * 2 + dir) * 1024 + ch];
        float2* cp = (float2*)car + ((size_t)dir * 640 + c0) * 1024 + ch;
#pragma unroll 8
        for (int s = 0; s < nc; ++s) { const int c = dir ? nc - 1 - s : s; const float2 v = cp[(size_t)c * 1024];
            cp[(size_t)c * 1024].y = h; h = __expf(v.x) * h + v.y; }
        if (seq < 16) out_state[(((size_t)seq * 2 + j) * 2 + dir) * 1024 + ch] = h;
    }
}
__device__ __forceinline__ void scan3_phase(const unsigned* AB, const float* car, const bf16_t* YB, bf16_t* Gout) {
    const int gt = opaque_bid() * 512 + opaque_tid(), NT = gridDim.x * 512;
    for (int it = gt; it < 640 * 512; it += NT) {
        const int cp = it & 511, c = it >> 9, ch = cp * 2;
        const size_t rb = (size_t)c * 32 * 1024 + ch;
        u32x2 vf[32], vb[32]; unsigned yv[32];
        const f32x4 cif = *(const f32x4*)(car + (((size_t)0 * 640 + c) * 1024 + ch) * 2), cib = *(const f32x4*)(car + (((size_t)1 * 640 + c) * 1024 + ch) * 2);
#pragma unroll
        for (int t = 0; t < 32; ++t) vf[t] = *(const u32x2*)(AB + rb + (size_t)t * 1024);
#pragma unroll
        for (int t = 0; t < 32; ++t) vb[t] = *(const u32x2*)(AB + (size_t)M * 1024 + rb + (size_t)t * 1024);
#pragma unroll
        for (int t = 0; t < 32; ++t) yv[t] = *(const unsigned*)(YB + rb + (size_t)t * 1024);
        asm volatile("" ::: "memory");
        float hf[32][2];
        { float h0 = cif[1], h1 = cif[3];
#pragma unroll
          for (int t = 0; t < 32; ++t) { h0 = __expf(bflo(vf[t].x)) * h0 + bfhi(vf[t].x); h1 = __expf(bflo(vf[t].y)) * h1 + bfhi(vf[t].y); hf[t][0] = h0; hf[t][1] = h1; } }
        { float h0 = cib[1], h1 = cib[3];
#pragma unroll
          for (int t = 31; t >= 0; --t) { h0 = __expf(bflo(vb[t].x)) * h0 + bfhi(vb[t].x); h1 = __expf(bflo(vb[t].y)) * h1 + bfhi(vb[t].y);
              *(unsigned*)(Gout + rb + (size_t)t * 1024) = pk2((hf[t][0] + h0) * bflo(yv[t]), (hf[t][1] + h1) * bfhi(yv[t])); } }
    }
}
__device__ __forceinline__ int kvrow_of(int row) { return row < MCTX ? row : MCTX + ((row - MCTX) >> 11) * KVB + ((row - MCTX) & 2047); }
__device__ __forceinline__ void mla_post_phase(const float* PROJ, const float* gq, const float* gkv, const float* rope, const float* cckv, const float* ckpe, int j,
                                               bf16_t* CQ, bf16_t* CKV, bf16_t* KPE, float* out_ckv, float* out_kpe) {
    const int tid_ = opaque_tid(), lane = tid_ & 63, gw = opaque_bid() * 8 + (tid_ >> 6), NGW = gridDim.x * 8;
    const f32x4 ga = *(const f32x4*)(gq + 4 * lane), gb = *(const f32x4*)(gq + 256 + 4 * lane), gk = *(const f32x4*)(gkv + 4 * lane);
#define MP_LOAD(r, A_, B_, C_, K_) do { if ((r) < M) { const float* pr_ = PROJ + (size_t)(r) * 1024; A_ = *(const f32x4*)(pr_ + 4 * lane); B_ = *(const f32x4*)(pr_ + 256 + 4 * lane); C_ = *(const f32x4*)(pr_ + 512 + 4 * lane); \
            K_ = *(const f32x2*)(pr_ + 768 + 2 * (lane & 31)); } \
        else { const int cr_ = (r) - M, bb_ = cr_ >> 8, s_ = cr_ & 255; A_ = (f32x4){0.f, 0.f, 0.f, 0.f}; B_ = A_; C_ = *(const f32x4*)(cckv + (((size_t)bb_ * 2 + j) * 256 + s_) * 256 + 4 * lane); \
            K_ = *(const f32x2*)(ckpe + (((size_t)bb_ * 2 + j) * 256 + s_) * 64 + 2 * (lane & 31)); } } while (0)
    f32x4 na, nb, nc; f32x2 nk;
    if (gw < M + 2048) MP_LOAD(gw, na, nb, nc, nk);
    for (int row = gw; row < M + 2048; row += NGW) {
        const f32x4 a = na, b = nb, cv = nc; const f32x2 kp = nk;
        if (row + NGW < M + 2048) MP_LOAD(row + NGW, na, nb, nc, nk);
        if (row < M) {
            const float ssq = wave_sum((a[0] * a[0] + a[1] * a[1]) + (a[2] * a[2] + a[3] * a[3]) + (b[0] * b[0] + b[1] * b[1]) + (b[2] * b[2] + b[3] * b[3]), lane);
            const float ssk = wave_sum((cv[0] * cv[0] + cv[1] * cv[1]) + (cv[2] * cv[2] + cv[3] * cv[3]), lane);
            const float rq = rsqrtf(ssq * (1.f / 512.f) + 1e-6f), rk = rsqrtf(ssk * (1.f / 256.f) + 1e-6f);
            const f32x4 ya = a * rq * ga, yb = b * rq * gb, yk = cv * rk * gk;
            *(u32x2*)(CQ + (size_t)row * 512 + 4 * lane) = (u32x2){pk2(ya[0], ya[1]), pk2(ya[2], ya[3])};
            *(u32x2*)(CQ + (size_t)row * 512 + 256 + 4 * lane) = (u32x2){pk2(yb[0], yb[1]), pk2(yb[2], yb[3])};
            const int kr = kvrow_of(row);
            *(u32x2*)(CKV + (size_t)kr * 256 + 4 * lane) = (u32x2){pk2(yk[0], yk[1]), pk2(yk[2], yk[3])};
            if (row < MCTX) { const int bb = row >> 8, t = row & 255; *(f32x4*)(out_ckv + (((size_t)bb * 2 + j) * 256 + t) * 256 + 4 * lane) = yk; }
            if (lane < 32) { float x1 = kp[0], x2 = kp[1];
                if (row < MCTX) { const int bb = row >> 8, t = row & 255; *(f32x2*)(out_kpe + (((size_t)bb * 2 + j) * 256 + t) * 64 + 2 * lane) = kp; }
                else { const int pos = (row - MCTX) & 2047; const f32x2 cs = *(const f32x2*)(rope + ((size_t)pos * 32 + lane) * 2);
                    const float o1 = x1 * cs[0] - x2 * cs[1], o2 = x1 * cs[1] + x2 * cs[0]; x1 = o1; x2 = o2; }
                *(unsigned*)(KPE + (size_t)kr * 64 + 2 * lane) = pk2(x1, x2); }
        } else {
            const int cr = row - M, bb = cr >> 8, s = cr & 255, kr = MCTX + bb * KVB + 2048 + s;
            *(u32x2*)(CKV + (size_t)kr * 256 + 4 * lane) = (u32x2){pk2(cv[0], cv[1]), pk2(cv[2], cv[3])};
            if (lane < 32) *(unsigned*)(KPE + (size_t)kr * 64 + 2 * lane) = pk2(kp[0], kp[1]);
        }
    }
#undef MP_LOAD
}

constexpr int AT_PE = 16384, AT_VT = 24576, ATT_BUF = 40960;
__device__ __forceinline__ void attn_phase(LAS unsigned char* lds, const bf16_t* Q, const bf16_t* KN, const bf16_t* KPE, const bf16_t* VT, bf16_t* O) {
    const int tid = opaque_tid(), lane = tid & 63, wave = __builtin_amdgcn_readfirstlane(tid >> 6), q32 = lane & 31, hi = lane >> 5;
    const int G = gridDim.x, bx = opaque_bid();
    const int xcd = bx & 7, idx = bx >> 3;
    const int pi_row = 16 * ((q32 >> 3) >> 1) + 8 * ((q32 >> 2) & 1) + 4 * ((q32 >> 3) & 1) + (q32 & 3);
    const unsigned laneN = (unsigned)(pi_row * 256 + (((pi_row & 15) ^ hi) * 16));
    const unsigned laneP = (unsigned)(AT_PE + pi_row * 128 + ((((pi_row >> 1) & 7) ^ hi) * 16));
    const unsigned laneV = (unsigned)(AT_VT + q32 * 128 + ((((q32 >> 1) & 7) ^ hi) * 16));
    const int rN = 8 * wave + (lane >> 4), cN = (lane & 15) ^ (rN & 15);
    const unsigned oN0 = (unsigned)(rN * 1024 + cN * 8) * 2u, oN1 = (unsigned)((rN + 4) * 1024 + (cN ^ 4) * 8) * 2u;
    const int rP = 8 * wave + (lane >> 3), cP = (lane & 7) ^ ((rP >> 1) & 7);
    const unsigned oP = (unsigned)(rP * 64 + cP * 8) * 2u;
    const int dV = 16 * wave + (lane >> 3), cV = (lane & 7) ^ ((dV >> 1) & 7);
    const unsigned oV0 = (unsigned)(dV * MKV + cV * 8) * 2u, oV1 = (unsigned)((dV + 8) * MKV + (cV ^ 4) * 8) * 2u;
    for (int ui = bx; ui < 512 + 128; ui += G) {
        int qrow0, kv0, ntile, h;
        if (ui < 512) {
            int bh, qb;
            if (G == 256) { const int r = ui >> 8; bh = r * 32 + xcd * 4 + (idx >> 3); qb = idx & 7; } else { bh = ui >> 3; qb = ui & 7; }
            const int b = bh >> 3; h = bh & 7; qrow0 = MCTX + b * 2048 + qb * 256; kv0 = MCTX + b * KVB; ntile = 36;
        } else { const int v = ui - 512, b = v >> 3; h = v & 7; qrow0 = b * 256; kv0 = b * 256; ntile = 4; }
        bf16x8 qf[12];
        { const char* qb_ = (const char*)(Q + (size_t)(qrow0 + wave * 32) * QW + h * 192); const unsigned qo_ = (unsigned)(q32 * QW + 8 * hi) * 2u;
#pragma unroll
          for (int ks = 0; ks < 12; ++ks) qf[ks] = *(const bf16x8*)(qb_ + 32 * ks + qo_); }
        f32x16 oacc[4];
#pragma unroll
        for (int d = 0; d < 4; ++d)
#pragma unroll
            for (int r = 0; r < 16; ++r) oacc[d][r] = 0.f;
        float m_run = -1e30f, l_run = 0.f;
        const char* bKn = (const char*)(KN + (size_t)kv0 * 1024 + h * 128);
        const char* bKp = (const char*)(KPE + (size_t)kv0 * 64);
        const char* bV = (const char*)(VT + (size_t)(h * 128) * MKV + kv0);
#define ATT_GLDS(g, l) __builtin_amdgcn_global_load_lds((const unsigned*)(g), (LAS unsigned*)(l), 16, 0, 0)
#define ATT_DMA(t, bufb) do { const char* k_ = bKn + (size_t)(t) * (64 * 1024 * 2); const char* p_ = bKp + (size_t)(t) * (64 * 64 * 2); const char* v_ = bV + (size_t)(t) * 128; \
        LAS unsigned char* d_ = lds + (bufb); \
        ATT_GLDS(k_ + oN0, d_ + (2 * wave) * 1024); ATT_GLDS(k_ + oN1, d_ + (2 * wave + 1) * 1024); ATT_GLDS(p_ + oP, d_ + AT_PE + wave * 1024); \
        ATT_GLDS(v_ + oV0, d_ + AT_VT + (2 * wave) * 1024); ATT_GLDS(v_ + oV1, d_ + AT_VT + (2 * wave + 1) * 1024); } while (0)
        asm volatile("s_waitcnt lgkmcnt(0)" ::: "memory"); __builtin_amdgcn_s_barrier(); asm volatile("" ::: "memory");
        ATT_DMA(0, 0); ATT_DMA(1, ATT_BUF);
        int bcur = 0;
        for (int t = 0; t < ntile; ++t) {
            if (t + 1 < ntile) asm volatile("s_waitcnt vmcnt(5)" ::: "memory"); else asm volatile("s_waitcnt vmcnt(0)" ::: "memory");
            asm volatile("s_waitcnt lgkmcnt(0)" ::: "memory"); __builtin_amdgcn_s_barrier(); asm volatile("" ::: "memory");
            const int bprev = bcur == 0 ? 2 * ATT_BUF : bcur - ATT_BUF;
            if (t + 2 < ntile) ATT_DMA(t + 2, bprev);
            const unsigned aN = laneN + (unsigned)bcur, aP = laneP + (unsigned)bcur, aV = laneV + (unsigned)bcur;
            bcur = bcur == 2 * ATT_BUF ? 0 : bcur + ATT_BUF;
            f32x16 s0, s1;
#pragma unroll
            for (int r = 0; r < 16; ++r) { s0[r] = 0.f; s1[r] = 0.f; }
#pragma unroll
            for (int ks = 0; ks < 12; ++ks) {
                const unsigned pa = ks < 8 ? (aN ^ (unsigned)(ks * 32)) : (aP ^ (unsigned)((ks - 8) * 32));
                const bf16x8 a0 = *(const LAS bf16x8*)(lds + pa), a1 = *(const LAS bf16x8*)(lds + pa + (ks < 8 ? 8192 : 4096));
                s0 = __builtin_amdgcn_mfma_f32_32x32x16_bf16(a0, qf[ks], s0, 0, 0, 0);
                s1 = __builtin_amdgcn_mfma_f32_32x32x16_bf16(a1, qf[ks], s1, 0, 0, 0);
            }
            float mx = s0[0];
#pragma unroll
            for (int r = 1; r < 16; ++r) mx = fmaxf(mx, s0[r]);
#pragma unroll
            for (int r = 0; r < 16; ++r) mx = fmaxf(mx, s1[r]);
            mx = fmaxf(mx, shfl_xor_l(mx, lane, 32));
            const float m_new = fmaxf(m_run, mx), alpha = __builtin_amdgcn_exp2f(m_run - m_new);
            const bool grow = __builtin_amdgcn_ballot_w64(m_new > m_run) != 0ull; m_run = m_new;
            float ls = 0.f;
#pragma unroll
            for (int r = 0; r < 16; ++r) { s0[r] = __builtin_amdgcn_exp2f(s0[r] - m_new); s1[r] = __builtin_amdgcn_exp2f(s1[r] - m_new); ls += s0[r] + s1[r]; }
            l_run = l_run * alpha + ls;
            if (grow) {
#pragma unroll
                for (int d = 0; d < 4; ++d)
#pragma unroll
                    for (int r = 0; r < 16; ++r) oacc[d][r] *= alpha;
            }
            bf16x8 pb[2][2];
#pragma unroll
            for (int jj = 0; jj < 2; ++jj) {
                u32x4 w0, w1;
                w0.x = pg8::cvt_pk_bf16(s0[8 * jj + 0], s0[8 * jj + 1]); w0.y = pg8::cvt_pk_bf16(s0[8 * jj + 2], s0[8 * jj + 3]);
                w0.z = pg8::cvt_pk_bf16(s0[8 * jj + 4], s0[8 * jj + 5]); w0.w = pg8::cvt_pk_bf16(s0[8 * jj + 6], s0[8 * jj + 7]);
                w1.x = pg8::cvt_pk_bf16(s1[8 * jj + 0], s1[8 * jj + 1]); w1.y = pg8::cvt_pk_bf16(s1[8 * jj + 2], s1[8 * jj + 3]);
                w1.z = pg8::cvt_pk_bf16(s1[8 * jj + 4], s1[8 * jj + 5]); w1.w = pg8::cvt_pk_bf16(s1[8 * jj + 6], s1[8 * jj + 7]);
                pb[0][jj] = __builtin_bit_cast(bf16x8, w0); pb[1][jj] = __builtin_bit_cast(bf16x8, w1);
            }
#pragma unroll
            for (int hf = 0; hf < 2; ++hf)
#pragma unroll
                for (int jj = 0; jj < 2; ++jj) {
                    const unsigned pv = aV ^ (unsigned)(hf * 64 + jj * 32);
#pragma unroll
                    for (int d = 0; d < 4; ++d) {
                        const bf16x8 av = *(const LAS bf16x8*)(lds + pv + d * 4096);
                        oacc[d] = __builtin_amdgcn_mfma_f32_32x32x16_bf16(av, pb[hf][jj], oacc[d], 0, 0, 0);
                    }
                }
        }
        const float lt = l_run + shfl_xor_l(l_run, lane, 32), inv = 1.f / lt;
        char* ob_ = (char*)(O + (size_t)(qrow0 + wave * 32) * 1024 + h * 128); const unsigned oo_ = (unsigned)(q32 * 1024 + 4 * hi) * 2u;
#pragma unroll
        for (int d = 0; d < 4; ++d)
#pragma unroll
            for (int g4 = 0; g4 < 4; ++g4)
                *(u32x2*)(ob_ + (d * 32 + g4 * 8) * 2 + oo_) = (u32x2){pk2(oacc[d][4 * g4 + 0] * inv, oacc[d][4 * g4 + 1] * inv), pk2(oacc[d][4 * g4 + 2] * inv, oacc[d][4 * g4 + 3] * inv)};
#undef ATT_GLDS
#undef ATT_DMA
    }
    asm volatile("s_waitcnt vmcnt(0) lgkmcnt(0)" ::: "memory"); __builtin_amdgcn_s_barrier(); asm volatile("" ::: "memory");
}

#define XB_TMO      128
#define XB_XCNT(j)  (256  + 64 * (j))
#define XB_XSUB(j)  (1280 + 64 * (j))
#define XB_XGEN(j)  (2304 + 64 * (j))
#define XB_TOP      3328
#define XB_TOPGEN   3392
#define XCD_BAR_WORDS 3456
#define XB_SPIN_CAP (1u << 22)
__device__ __forceinline__ unsigned xb_ld(unsigned* p)              { return __hip_atomic_load(p, __ATOMIC_RELAXED, __HIP_MEMORY_SCOPE_AGENT); }
__device__ __forceinline__ unsigned xb_add(unsigned* p, unsigned v) { return __hip_atomic_fetch_add(p, v, __ATOMIC_RELAXED, __HIP_MEMORY_SCOPE_AGENT); }
__device__ __forceinline__ unsigned xb_xcc_id() { return (unsigned)__builtin_amdgcn_s_getreg((3 << 11) | 20) & 0xFu; }
#define XB_SPIN(cond, bar) do { unsigned _sp = 0; while (cond) { __builtin_amdgcn_s_sleep(1); \
    if ((++_sp & 255u) == 0u) { if (xb_ld(&(bar)[XB_TMO])) break; if (_sp > XB_SPIN_CAP) { atomicAdd(&(bar)[XB_TMO], 1u); break; } } } } while (0)
struct XcdBarrier { unsigned* bar; unsigned x; volatile LAS unsigned* st; };
__device__ __forceinline__ XcdBarrier xcd_barrier_post(unsigned* bar, volatile LAS unsigned* st) {
    XcdBarrier b; b.bar = bar; b.x = xb_xcc_id(); b.st = st;
    if (threadIdx.x == 0) (void)xb_add(&bar[XB_XCNT(b.x)], 1u);
    return b;
}
__device__ __forceinline__ void xcd_barrier_complete(unsigned* bar, unsigned x, unsigned& nloc, unsigned& nx) {
    const unsigned G = gridDim.x * gridDim.y * gridDim.z;
    unsigned sum, cnt, mine, sp = 0u;
    for (;;) {
        sum = 0u; cnt = 0u; mine = 0u;
#pragma unroll
        for (unsigned j = 0; j < 16; ++j) { const unsigned c = xb_ld(&bar[XB_XCNT(j)]); sum += c; cnt += (c > 0u) ? 1u : 0u; mine = (j == x) ? c : mine; }
        if (sum == G) break;
        __builtin_amdgcn_s_sleep(1);
        if ((++sp & 255u) == 0u) { if (xb_ld(&bar[XB_TMO])) break; if (sp > XB_SPIN_CAP) { atomicAdd(&bar[XB_TMO], 1u); break; } }
    }
    nloc = mine > 0u ? mine : 1u; nx = cnt > 0u ? cnt : 1u;
}
__device__ __forceinline__ void xcd_barrier(const XcdBarrier& b) {
    asm volatile("s_waitcnt vmcnt(0)" ::: "memory");
    __syncthreads();
    if (threadIdx.x == 0) {
        unsigned* bar = b.bar;
        __builtin_amdgcn_s_waitcnt(0);
        unsigned nloc = b.st[0], nx = b.st[1];
        if (nloc == 0u) { xcd_barrier_complete(bar, b.x, nloc, nx); b.st[0] = nloc; b.st[1] = nx; }
        const unsigned old = xb_add(&bar[XB_XSUB(b.x)], 1u);
        const unsigned gen = old / nloc;
        if (old + 1u == (gen + 1u) * nloc) {
            __builtin_amdgcn_fence(__ATOMIC_RELEASE, "agent");
            asm volatile("s_waitcnt vmcnt(0)" ::: "memory");
            const unsigned og = xb_add(&bar[XB_TOP], 1u);
            const unsigned tg = og / nx;
            if (og + 1u == (tg + 1u) * nx) xb_add(&bar[XB_TOPGEN], 1u);
            else XB_SPIN(xb_ld(&bar[XB_TOPGEN]) == tg, bar);
            __builtin_amdgcn_fence(__ATOMIC_ACQUIRE, "agent");
            xb_add(&bar[XB_XGEN(b.x)], 1u);
            asm volatile("s_waitcnt vmcnt(0)" ::: "memory");
        } else {
            XB_SPIN(xb_ld(&bar[XB_XGEN(b.x)]) == gen, bar);
            __builtin_amdgcn_fence(__ATOMIC_ACQUIRE, "agent");
            asm volatile("s_waitcnt vmcnt(0)" ::: "memory");
        }
    }
    __syncthreads();
}

constexpr int N_PHASES = 39;
__global__ void __launch_bounds__(512, 2) fwd_kernel(Params p) {
    extern __shared__ __attribute__((aligned(16))) unsigned char lds_raw[];
    LAS unsigned char* lds = (LAS unsigned char*)lds_raw;
    cg::grid_group grid = cg::this_grid();
    const int lo = p.ph_lo, hi = p.ph_hi;
    int k = 0, l = 0;
    if (threadIdx.x < 16) ((LAS unsigned*)(lds + 131072))[threadIdx.x] = 0u;
    __syncthreads();
    XcdBarrier xbar = xcd_barrier_post((unsigned*)(p.ws + WS_BAR), (volatile LAS unsigned*)(lds + 131072));
#ifndef EN_MASK
#define EN_MASK 0xFFFFFFFFu
#endif
#define PH_BEGIN(id) if (((EN_MASK >> (id)) & 1u) && k >= lo && k < hi) { KArgP q = opaque_kernarg(); unsigned char* ws = q->ws; float* X = q->out; \
        const int j = l >> 1; const float* modl = (const float*)(ws + WS_MOD) + (size_t)l * 9 * 6144; const float* rope = (const float*)(ws + WS_ROPE); bf16_t* H = (bf16_t*)(ws + WS_H); \
        const float* xb0 = l == 0 ? q->in[I_XP] : X; const float* xb1 = l == 0 ? q->in[I_XS] : X + (size_t)MCTX * D; \
        bf16_t* XB = (bf16_t*)(ws + S_XB); bf16_t* YB = (bf16_t*)(ws + S_YB); bf16_t* XC = (bf16_t*)(ws + S_XC); unsigned* AB = (unsigned*)(ws + S_AB); float* car = (float*)(ws + S_CAR); \
        float* PROJ = (float*)(ws + S_PROJ); bf16_t* CQ = (bf16_t*)(ws + S_CQ); bf16_t* CKV = (bf16_t*)(ws + S_CKV); bf16_t* KPE = (bf16_t*)(ws + S_KPE); \
        bf16_t* Qb = (bf16_t*)(ws + S_Q); bf16_t* KN = (bf16_t*)(ws + S_KN); bf16_t* VT = (bf16_t*)(ws + S_VT); bf16_t* A2 = (bf16_t*)(ws + S_A2); \
        float* SS = (float*)(ws + WS_SS); const float* SWl = (const float*)(ws + WS_SW) + (size_t)l * 9 * 6144; bf16_t* OB = (bf16_t*)(ws + S_O); LAS float* RS = (LAS float*)(lds + 131072); (void)SS; (void)SWl; (void)OB; (void)RS; \
        (void)j; (void)modl; (void)rope; (void)H; (void)xb0; (void)xb1; (void)XB; (void)YB; (void)XC; (void)AB; (void)car; (void)PROJ; (void)CQ; (void)CKV; (void)KPE; (void)Qb; (void)KN; (void)VT; (void)A2; (void)X;
#define PH_END   if (k + 1 < hi) { if (hi < 0) grid.sync();   xcd_barrier(xbar); } } ++k;

    PH_BEGIN(0) phase0(q, lds); PH_END

    for (l = 0; l < 4; ++l) {
        if (l == 0) { PH_BEGIN(1) norm_phase(xb0, xb1, q->in[I_NMIX], modl, 1, H, SS); sw_phase((const float*)(ws + WS_MOD), ws, (float*)(ws + WS_SW)); PH_END }
        if ((l & 1) == 0) {
            PH_BEGIN(2) { EpiBf16<2, true> E{XB, YB, 1024, SS, SWl}; run_gemm(lds, H, 1024, (const bf16_t*)(ws + WS_WINT) + (size_t)j * 2048 * 1024, 1024, M, 2048, 1024, 0, 0, E); } PH_END
            PH_BEGIN(3) conv_phase(XB, XC, q->in[I_CONVW] + j * 4096, q->in[I_CONVB] + j * 1024); PH_END
            PH_BEGIN(4) { EpiGates E{XC, AB, q->in[I_BA] + j * 2048, q->in[I_BX] + j * 2048, (const float*)(ws + WS_SP) + j * 2048};
                       run_gemm(lds, XC, 1024, (const bf16_t*)(ws + WS_WGT) + (size_t)j * 4096 * 128, 128, M, 4096, 128, 1, 256, E); } PH_END
            PH_BEGIN(5) scan1_phase(AB, car); PH_END
            PH_BEGIN(6) scan2_phase(car, q->in[I_STATE], j, X + OUT_STATE); PH_END
            PH_BEGIN(7) scan3_phase(AB, car, YB, YB); PH_END
            PH_BEGIN(8) { EpiResid E{xb0, xb1, X, modl + 2 * 1024, H, q->in[I_NMLP] + l * 1024, modl + 4 * 1024, SS};
                       run_gemm(lds, YB, 1024, (const bf16_t*)(ws + WS_WOUTT) + (size_t)j * 1024 * 1024, 1024, M, 1024, 1024, 0, 0, E); } PH_END
        } else {
            PH_BEGIN(9) { EpiF32 E{PROJ, 1024, SS, SWl}; run_gemm(lds, H, 1024, (const bf16_t*)(ws + WS_WDQT) + (size_t)j * 1024 * 1024, 1024, M, 1024, 1024, 0, 0, E); } PH_END
            PH_BEGIN(10) mla_post_phase(PROJ, q->in[I_NQ] + j * 512, q->in[I_NKV] + j * 256, rope, q->in[I_CCKV], q->in[I_CKPE], j, CQ, CKV, KPE, X + OUT_CKV, X + OUT_KPE); PH_END
            PH_BEGIN(11) { EpiQ EQ{Qb, rope, 0.07216878364870322f * 1.4426950408889634f};
                       run_gemm(lds, CQ, 512, (const bf16_t*)(ws + WS_WUQT) + (size_t)j * 1536 * 512, 512, M, 1536, 512, 0, 0, EQ);
                       EpiDual EKV{KN, 1024, VT, MKV};
                       run_gemm_dual(lds, CKV, (const bf16_t*)(ws + WS_WUKT) + (size_t)j * 1024 * 256, MKV, 1024,
                                     (const bf16_t*)(ws + WS_WUVT) + (size_t)j * 1024 * 256, CKV, 1024, MKV, 256, 256, EKV); } PH_END
            PH_BEGIN(12) attn_phase(lds, Qb, KN, KPE, VT, OB); PH_END
            PH_BEGIN(13) { EpiResid E{xb0, xb1, X, modl + 2 * 1024, H, q->in[I_NMLP] + l * 1024, modl + 4 * 1024, SS};
                       run_gemm(lds, OB, 1024, (const bf16_t*)(ws + WS_WOT) + (size_t)j * 1024 * 1024, 1024, M, 1024, 1024, 0, 0, E); } PH_END
        }
        PH_BEGIN(15) { EpiBf16<1, true> E{A2, nullptr, 4096, SS, SWl + 2048}; run_gemm(lds, H, 1024, (const bf16_t*)(ws + WS_W1T) + (size_t)l * 4096 * 1024, 1024, M, 4096, 1024, 0, 0, E); } PH_END
        PH_BEGIN(16) { const int G_ = (int)gridDim.x; const bool split = (G_ == 256);
                       EpiResid E{X, X + (size_t)MCTX * D, X, modl + 5 * 1024, l < 3 ? H : nullptr, q->in[I_NMIX] + (l + 1) * 1024, modl + 9 * 6144 + 1024, SS};
                       const bf16_t* W2 = (const bf16_t*)(ws + WS_W2T) + (size_t)l * 1024 * 4096;
                       run_gemm(lds, A2, 4096, W2, 4096, M, 1024, 4096, 0, 0, E, split ? 256 : (1 << 30));
                       if (split) { EpiPartial EP{(float*)(ws + S_PART), 256, 80, 4}; run_gemm_split(lds, A2, 4096, W2, 4096, M, 1024, 1024, 256, EP); } } PH_END
        PH_BEGIN(17) { if ((int)gridDim.x == 256) split_reduce_phase((const float*)(ws + S_PART), X, modl + 5 * 1024, 256, 80, 4, l < 3 ? H : nullptr, q->in[I_NMIX] + (l + 1) * 1024, modl + 9 * 6144 + 1024, SS); } PH_END
    }
    PH_BEGIN(18) final_norm_phase(X, q->in[I_FN]); PH_END
#undef PH_BEGIN
#undef PH_END
}

#ifndef MULTI_LAUNCH
#define MULTI_LAUNCH 0
#endif
extern "C" void kernel_launch(void* const* d_in, const int* in_sizes, int n_in, void* d_out, int out_size, void* d_ws, size_t ws_size, hipStream_t stream) {
    static int grid = 0;
    if (grid == 0) {
        int dev = 0, cus = 0, per_cu = 0;
        hipGetDevice(&dev);
        hipDeviceGetAttribute(&cus, hipDeviceAttributeMultiprocessorCount, dev);
        hipFuncSetAttribute((const void*)fwd_kernel, hipFuncAttributeMaxDynamicSharedMemorySize, LDS_BYTES);
        hipOccupancyMaxActiveBlocksPerMultiprocessor(&per_cu, (const void*)fwd_kernel, 512, LDS_BYTES);
        if (per_cu < 1) per_cu = 1;
        grid = cus * 1;
        if (ws_size < WS_END || n_in != 29) { fprintf(stderr, "kernel_launch: ws_size %zu < %zu or n_in %d != 29\n", ws_size, (size_t)WS_END, n_in); }
        (void)hipGetLastError();
    }
    (void)hipMemsetAsync((char*)d_ws + WS_BAR, 0, BAR_BYTES, stream);
    Params p{};
    for (int i = 0; i < 29; ++i) p.in[i] = (const float*)d_in[i];
    p.out = (float*)d_out; p.ws = (unsigned char*)d_ws;
#if MULTI_LAUNCH
    for (int k = 0; k < N_PHASES; ++k) { p.ph_lo = k; p.ph_hi = k + 1; hipLaunchKernelGGL(fwd_kernel, dim3(grid), dim3(512), LDS_BYTES, stream, p); }
#else
    p.ph_lo = 0; p.ph_hi = N_PHASES;
    void* args[] = {&p};
    hipError_t e = hipLaunchCooperativeKernel((const void*)fwd_kernel, dim3(grid), dim3(512), args, LDS_BYTES, stream);
    if (e != hipSuccess) fprintf(stderr, "cooperative launch failed: %s (grid %d)\n", hipGetErrorString(e), grid);
#endif
}
```
